# Optimizing an MI355X kernel written in HIP

```python
import jax, jax.numpy as jnp
from jax import lax
import numpy as np

D_MODEL = 2048
BATCH = 8
SEQ = 4096
DEPTH = 4

N_A_LAYERS = DEPTH // 2
N_B_LAYERS = DEPTH - N_A_LAYERS
HG_HEADS = 16
HG_DK = D_MODEL // HG_HEADS
HG_DV = D_MODEL // HG_HEADS
HG_CHUNK = 64
MLA_HEADS = 16
MLA_NOPE = 128
MLA_ROPE = 64
MLA_V = 128
MLA_QK = MLA_NOPE + MLA_ROPE
Q_LORA = 512
KV_LORA = 512
ROPE_THETA = 10000.0
Q_BLOCK = 128
D_FF = 4 * D_MODEL
N_MOD = 6
EPS = 1e-6

kernel_name = "hybrid_hgrn2_mla_yoco_adaln"


def rms_norm(x, gain):
    xf = x.astype(jnp.float32)
    y = xf * lax.rsqrt(jnp.mean(xf * xf, axis=-1, keepdims=True) + EPS)
    return (y * gain.astype(jnp.float32)).astype(x.dtype)


def modulate(h, shift, scale):
    return h * (1 + scale[:, None, :]) + shift[:, None, :]


def rope_tables(positions):
    inv_freq = 1.0 / (ROPE_THETA ** (jnp.arange(0, MLA_ROPE, 2, dtype=jnp.float32) / MLA_ROPE))
    ang = positions.astype(jnp.float32)[..., None] * inv_freq
    return jnp.cos(ang)[:, :, None, :], jnp.sin(ang)[:, :, None, :]


def apply_rope(t, cos, sin):
    tf = t.astype(jnp.float32)
    t1, t2 = jnp.split(tf, 2, axis=-1)
    out = jnp.concatenate([t1 * cos - t2 * sin, t2 * cos + t1 * sin], axis=-1)
    return out.astype(t.dtype)


def squared_relu_mlp(h, w1, w2):
    a = jax.nn.relu(h @ w1)
    return (a * a) @ w2


def hgrn2_mixer(h, w_in, lb, o_gain, w_out):
    B, S, D = h.shape
    f32 = jnp.float32
    proj = h @ w_in
    q, fz, i, g = jnp.split(proj, 4, axis=-1)
    fz = fz.astype(f32)
    lbf = lb.astype(f32)
    log_f = jnp.logaddexp(jnp.log(lbf), jnp.log1p(-lbf) + jax.nn.log_sigmoid(fz))
    k = (1.0 - lbf) * jax.nn.sigmoid(-fz)

    n_chunks = S // HG_CHUNK

    def to_chunks(t, d):
        t = t.astype(f32).reshape(B, n_chunks, HG_CHUNK, HG_HEADS, d)
        return t.transpose(1, 0, 3, 2, 4)

    qc = to_chunks(q, HG_DK) * (HG_DK ** -0.5)
    kc = to_chunks(k, HG_DK)
    vc = to_chunks(i, HG_DV)
    lfc = to_chunks(log_f, HG_DK)
    tri = jnp.tril(jnp.ones((HG_CHUNK, HG_CHUNK), dtype=bool))

    def step(state, inp):
        q_, k_, v_, lf_ = inp
        b = jnp.cumsum(lf_, axis=2)
        diff = b[:, :, :, None, :] - b[:, :, None, :, :]
        decay = jnp.where(tri[:, :, None], jnp.exp(jnp.minimum(diff, 0.0)), 0.0)
        scores = jnp.einsum('bhtk,bhtsk,bhsk->bhts', q_, decay, k_)
        o = scores @ v_ + jnp.einsum('bhtk,bhkv->bhtv', q_ * jnp.exp(b), state)
        b_last = b[:, :, -1:, :]
        state = (jnp.exp(b_last[:, :, 0, :, None]) * state
                 + jnp.einsum('bhsk,bhsv->bhkv', k_ * jnp.exp(b_last - b), v_))
        return state, o

    state0 = jnp.zeros((B, HG_HEADS, HG_DK, HG_DV), f32)
    _, o = lax.scan(step, state0, (qc, kc, vc, lfc))
    o = o.transpose(1, 0, 3, 2, 4).reshape(B, S, HG_HEADS, HG_DV)
    o = rms_norm(o, o_gain).reshape(B, S, D)
    o = o.astype(h.dtype) * jax.nn.silu(g)
    return o @ w_out


def mla_shared_kv(x, cond, kv_ada_w, kv_ada_b, kv_in_norm, w_dkv, kv_lat_norm, w_ukv, k_gain, cos, sin):
    B, S, _ = x.shape
    shift, scale = jnp.split(cond @ kv_ada_w + kv_ada_b, 2, axis=-1)
    h = modulate(rms_norm(x, kv_in_norm), shift, scale)
    ckv = h @ w_dkv
    c_lat = rms_norm(ckv[..., :KV_LORA], kv_lat_norm)
    k_pe = ckv[..., KV_LORA:]
    kv = (c_lat @ w_ukv).reshape(B, S, MLA_HEADS, MLA_NOPE + MLA_V)
    k_nope, v = kv[..., :MLA_NOPE], kv[..., MLA_NOPE:]
    k = jnp.concatenate([k_nope, jnp.broadcast_to(k_pe[:, :, None, :], (B, S, MLA_HEADS, MLA_ROPE))], axis=-1)
    k = rms_norm(k, k_gain)
    k = jnp.concatenate([k[..., :MLA_NOPE], apply_rope(k[..., MLA_NOPE:], cos, sin)], axis=-1)
    return k.transpose(0, 2, 1, 3), v.transpose(0, 2, 1, 3)


def mla_mixer(h, k, v, w_dq, q_lat_norm, w_uq, q_gain, w_o, cos, sin):
    B, S, _ = h.shape
    cq = rms_norm(h @ w_dq, q_lat_norm)
    q = (cq @ w_uq).reshape(B, S, MLA_HEADS, MLA_QK)
    q = rms_norm(q, q_gain)
    q = jnp.concatenate([q[..., :MLA_NOPE], apply_rope(q[..., MLA_NOPE:], cos, sin)], axis=-1)
    n_blocks = S // Q_BLOCK
    qb = q.reshape(B, n_blocks, Q_BLOCK, MLA_HEADS, MLA_QK).transpose(1, 0, 3, 2, 4)
    starts = jnp.arange(n_blocks, dtype=jnp.int32) * Q_BLOCK
    key_idx = jnp.arange(S, dtype=jnp.int32)
    sm_scale = MLA_QK ** -0.5

    def attend(args):
        q_blk, start = args
        s = jnp.einsum('bhqd,bhkd->bhqk', q_blk, k, preferred_element_type=jnp.float32) * sm_scale
        q_idx = start + jnp.arange(Q_BLOCK, dtype=jnp.int32)
        s = jnp.where(key_idx[None, :] <= q_idx[:, None], s, -jnp.inf)
        p = jax.nn.softmax(s, axis=-1)
        return jnp.einsum('bhqk,bhkd->bhqd', p.astype(v.dtype), v)

    o = lax.map(attend, (qb, starts))
    o = o.transpose(1, 0, 3, 2, 4).reshape(B, S, MLA_HEADS * MLA_V)
    return o @ w_o


def setup_inputs(seed: int = 0) -> dict:
    key = jax.random.key(seed)
    ks = jax.random.split(key, 32)
    f32 = jnp.float32

    def nrm(k, shape, scale):
        return jax.random.normal(k, shape, f32) * scale

    def gain(k, shape):
        return 1.0 + 0.02 * jax.random.normal(k, shape, f32)

    D = D_MODEL
    offset = jax.random.randint(ks[2], (BATCH, 1), 0, 1024, dtype=jnp.int32)
    positions = (offset + jnp.arange(SEQ, dtype=jnp.int32)[None, :]).astype(jnp.int32)
    return {
        "x": nrm(ks[0], (BATCH, SEQ, D), 1.0),
        "c": nrm(ks[1], (BATCH, D), 1.0),
        "positions": positions,
        "ada_w": nrm(ks[3], (DEPTH, D, N_MOD * D), 0.5 * D ** -0.5),
        "ada_b": nrm(ks[4], (DEPTH, N_MOD * D), 0.02),
        "norm_mix": gain(ks[5], (DEPTH, D)),
        "norm_mlp": gain(ks[6], (DEPTH, D)),
        "mlp_w1": nrm(ks[7], (DEPTH, D, D_FF), D ** -0.5),
        "mlp_w2": nrm(ks[8], (DEPTH, D_FF, D), D_FF ** -0.5),
        "hg_w_in": nrm(ks[9], (N_A_LAYERS, D, 4 * D), D ** -0.5),
        "hg_lower": nrm(ks[10], (N_A_LAYERS + 1, HG_HEADS * HG_DK), 0.1),
        "hg_o_norm": gain(ks[11], (N_A_LAYERS, HG_DV)),
        "hg_w_out": nrm(ks[12], (N_A_LAYERS, D, D), D ** -0.5),
        "kv_ada_w": nrm(ks[13], (D, 2 * D), 0.5 * D ** -0.5),
        "kv_ada_b": nrm(ks[14], (2 * D,), 0.02),
        "kv_in_norm": gain(ks[15], (D,)),
        "mla_w_dkv": nrm(ks[16], (D, KV_LORA + MLA_ROPE), D ** -0.5),
        "mla_kv_norm": gain(ks[17], (KV_LORA,)),
        "mla_w_ukv": nrm(ks[18], (KV_LORA, MLA_HEADS * (MLA_NOPE + MLA_V)), KV_LORA ** -0.5),
        "mla_k_norm": gain(ks[19], (MLA_QK,)),
        "mla_w_dq": nrm(ks[20], (N_B_LAYERS, D, Q_LORA), D ** -0.5),
        "mla_q_lat_norm": gain(ks[21], (N_B_LAYERS, Q_LORA)),
        "mla_w_uq": nrm(ks[22], (N_B_LAYERS, Q_LORA, MLA_HEADS * MLA_QK), Q_LORA ** -0.5),
        "mla_q_norm": gain(ks[23], (N_B_LAYERS, MLA_QK)),
        "mla_w_o": nrm(ks[24], (N_B_LAYERS, MLA_HEADS * MLA_V, D), (MLA_HEADS * MLA_V) ** -0.5),
    }


def reference(x, c, positions, ada_w, ada_b, norm_mix, norm_mlp, mlp_w1, mlp_w2,
              hg_w_in, hg_lower, hg_o_norm, hg_w_out,
              kv_ada_w, kv_ada_b, kv_in_norm, mla_w_dkv, mla_kv_norm, mla_w_ukv, mla_k_norm,
              mla_w_dq, mla_q_lat_norm, mla_w_uq, mla_q_norm, mla_w_o):
    cond = jax.nn.silu(c)
    cos, sin = rope_tables(positions)
    lb_all = jnp.cumsum(jax.nn.softmax(hg_lower.astype(jnp.float32), axis=0), axis=0)[:N_A_LAYERS]
    k_shared = None
    v_shared = None
    for layer in range(DEPTH):
        mod = cond @ ada_w[layer] + ada_b[layer]
        sh1, sc1, g1, sh2, sc2, g2 = jnp.split(mod, N_MOD, axis=-1)
        if layer == N_A_LAYERS:
            k_shared, v_shared = mla_shared_kv(x, cond, kv_ada_w, kv_ada_b, kv_in_norm, mla_w_dkv,
                                               mla_kv_norm, mla_w_ukv, mla_k_norm, cos, sin)
        h = modulate(rms_norm(x, norm_mix[layer]), sh1, sc1)
        if layer < N_A_LAYERS:
            y = hgrn2_mixer(h, hg_w_in[layer], lb_all[layer], hg_o_norm[layer], hg_w_out[layer])
        else:
            j = layer - N_A_LAYERS
            y = mla_mixer(h, k_shared, v_shared, mla_w_dq[j], mla_q_lat_norm[j], mla_w_uq[j],
                          mla_q_norm[j], mla_w_o[j], cos, sin)
        x = x + g1[:, None, :] * y.astype(x.dtype)
        h = modulate(rms_norm(x, norm_mlp[layer]), sh2, sc2)
        x = x + g2[:, None, :] * squared_relu_mlp(h, mlp_w1[layer], mlp_w2[layer]).astype(x.dtype)
    return x
```

```cpp
#include <hip/hip_runtime.h>
#include <cstdio>
#include <cstdint>

#ifndef MK_MULTI
#define MK_MULTI 0
#endif

namespace pg8 {
#define PG8_LAS __attribute__((address_space(3)))
typedef unsigned short bf16_t;
typedef short bf16x8 __attribute__((ext_vector_type(8)));
typedef float f32x4 __attribute__((ext_vector_type(4)));
typedef unsigned u32x4 __attribute__((ext_vector_type(4)));
constexpr int BM = 256, BK = 64, HALF = 128, HTB = HALF * BK * 2, STAGE_BYTES = 8 * HTB, NXCD = 8, WGM = 8;

__host__ __device__ __forceinline__ int lds_byte(int r, int c) { const int st = (r >> 4) * 2 + (c >> 5), rr = r & 15, cc = c & 31, ob = rr * 64 + cc * 2; return st * 1024 + (ob ^ (((ob >> 9) & 1) << 5)); }
__host__ __device__ __forceinline__ void stage_rc(int b, int& R, int& C) { const int st = b / 1024, sb = b % 1024, swz = sb ^ (((sb >> 9) & 1) << 5); R = (st >> 1) * 16 + swz / 64; C = (st & 1) * 32 + (swz % 64) / 2; }
__host__ __device__ __forceinline__ int perm32(int rho) { const int n = rho >> 4, i = rho & 15; return 8 * (i >> 2) + 4 * n + (i & 3); }

struct Unit { int pm, pn; };
struct Gemm { const bf16_t* A; const bf16_t* Bt; int M, N, K; };

struct StaticOrder {
    int nM, nN, nwg, G, c;
    __host__ __device__ void init(int M, int N, int G_, int c_) { nM = M / BM; nN = N / BM; nwg = nM * nN; G = G_; c = c_; }
    __host__ __device__ bool next(int i, Unit& u) const {
        const long L = (long)i * G + c; if (L >= nwg) return false;
        int wgid = (int)L; { const int q = nwg / NXCD, r = nwg % NXCD, xcd = wgid % NXCD, off = wgid / NXCD; wgid = (xcd < r ? xcd * (q + 1) : r * (q + 1) + (xcd - r) * q) + off; }
        const int nig = WGM * nN, gid = wgid / nig, fm = gid * WGM, gsz = (nM - fm) < WGM ? (nM - fm) : WGM;
        u.pm = fm + ((wgid % nig) % gsz); u.pn = (wgid % nig) / gsz; return true;
    }
    __device__ __forceinline__ void a_ready(const Unit&) const {}
    __device__ __forceinline__ void done(const Unit&) const {}
};

__device__ __forceinline__ unsigned cvt_pk_bf16(float lo, float hi) { unsigned r; asm volatile("v_cvt_pk_bf16_f32 %0, %1, %2" : "=v"(r) : "v"(lo), "v"(hi)); return r; }

template <int ACT  > struct EpiBf16 {
    static constexpr bool PERM = true, AFTER_DRAIN = false;
    bf16_t* O; int ldc;
    __device__ __forceinline__ void operator()(const f32x4 (&acc)[2][2][4][2], const Unit& u, int wr, int wc, int fr, int fq) const {
        const int row0 = u.pm * BM + wr * 64 + fr; const int col0 = u.pn * BM + wc * 32 + 8 * fq;
#pragma unroll
        for (int ai = 0; ai < 2; ++ai)
#pragma unroll
            for (int m = 0; m < 4; ++m) { bf16_t* rowp = O + (size_t)(row0 + ai * HALF + m * 16) * ldc + col0;
#pragma unroll
                for (int bj = 0; bj < 2; ++bj) { f32x4 v0 = acc[ai][bj][m][0], v1 = acc[ai][bj][m][1];
                    if (ACT == 1) {
#pragma unroll
                        for (int j = 0; j < 4; ++j) { const float a = fmaxf(v0[j], 0.f), b = fmaxf(v1[j], 0.f); v0[j] = a * a; v1[j] = b * b; } }
                    u32x4 w; w.x = cvt_pk_bf16(v0[0], v0[1]); w.y = cvt_pk_bf16(v0[2], v0[3]); w.z = cvt_pk_bf16(v1[0], v1[1]); w.w = cvt_pk_bf16(v1[2], v1[3]);
                    *(u32x4*)(rowp + bj * HALF) = w; } }
    }
};
struct EpiF32 {
    static constexpr bool PERM = false, AFTER_DRAIN = false;
    float* C; int ldc;
    __device__ __forceinline__ void operator()(const f32x4 (&acc)[2][2][4][2], const Unit& u, int wr, int wc, int fr, int fq) const {
        const int row0 = u.pm * BM + wr * 64 + fr, col0 = u.pn * BM + wc * 32 + 4 * fq;
#pragma unroll
        for (int ai = 0; ai < 2; ++ai)
#pragma unroll
            for (int m = 0; m < 4; ++m) { float* rowp = C + (size_t)(row0 + ai * HALF + m * 16) * ldc + col0;
#pragma unroll
                for (int bj = 0; bj < 2; ++bj)
#pragma unroll
                    for (int n = 0; n < 2; ++n) *(f32x4*)(rowp + bj * HALF + n * 16) = acc[ai][bj][m][n]; }
    }
};
struct EpiResid {
    static constexpr bool PERM = false, AFTER_DRAIN = false;
    const float* base; float* out; int ldc; const float* gate; int gstride;
    __device__ __forceinline__ void operator()(const f32x4 (&acc)[2][2][4][2], const Unit& u, int wr, int wc, int fr, int fq) const {
        const int row0 = u.pm * BM + wr * 64 + fr, col0 = u.pn * BM + wc * 32 + 4 * fq;
        const float* gp = gate + (size_t)(u.pm >> 4) * gstride + col0;
        f32x4 gv[2][2];
#pragma unroll
        for (int bj = 0; bj < 2; ++bj)
#pragma unroll
            for (int n = 0; n < 2; ++n) gv[bj][n] = *(const f32x4*)(gp + bj * HALF + n * 16);
#pragma unroll
        for (int ai = 0; ai < 2; ++ai)
#pragma unroll
            for (int m = 0; m < 4; ++m) { const size_t off = (size_t)(row0 + ai * HALF + m * 16) * ldc + col0;
#pragma unroll
                for (int bj = 0; bj < 2; ++bj)
#pragma unroll
                    for (int n = 0; n < 2; ++n) { const f32x4 bs = *(const f32x4*)(base + off + bj * HALF + n * 16);
                        *(f32x4*)(out + off + bj * HALF + n * 16) = bs + gv[bj][n] * acc[ai][bj][m][n]; }
                asm volatile("" ::: "memory"); }
    }
};

template <class Epi, class Sched, bool ALIGN_EPI = false, bool SP2 = false>
__device__ __forceinline__ void gemm_phase(PG8_LAS unsigned char* lds, const Gemm g, const Sched& S, const Epi& E) {
    int tid_ = threadIdx.x; asm volatile("" : "+v"(tid_));
    const int tid = tid_, wid = __builtin_amdgcn_readfirstlane(tid >> 6), lane = tid & 63, wr = wid >> 2, wc = wid & 3, fr = lane & 15, fq = lane >> 4;
    const int K = g.K, nt = K / BK;
    unsigned voffA[2], voffB[2];
#pragma unroll
    for (int i = 0; i < 2; ++i) { int R, C; stage_rc(tid * 16 + i * 8192, R, C); const int Rb = Epi::PERM ? ((R & ~31) + perm32(R & 31)) : R;
        voffA[i] = (unsigned)(R * K + C) * 2u; voffB[i] = (unsigned)(Rb * K + C) * 2u; }
    const size_t kstep = (size_t)(BK * 2);
    const size_t hstep = (size_t)HALF * K * 2;
    const size_t tstep = 2 * hstep;
    const unsigned ldsw = (unsigned)wid * 1024u;
    const int aoff = lds_byte(wr * 64 + fr, fq * 8), boff = lds_byte(wc * 32 + fr, fq * 8);
#define PG8_SA(b, h) (((b) * 2 + (h)) * HTB)
#define PG8_SB(b, h) ((4 + (b) * 2 + (h)) * HTB)
#define PG8_STAGE(bufoff, gbase, voff) do { _Pragma("unroll") for (int _i = 0; _i < 2; ++_i) \
        __builtin_amdgcn_global_load_lds((const unsigned*)((const char*)(gbase) + (voff)[_i]), (PG8_LAS unsigned*)(lds + (bufoff) + ldsw + _i * 8192), 16, 0, 0); } while (0)
#define PG8_LDA(dst, b, h) do { _Pragma("unroll") for (int m = 0; m < 4; ++m) _Pragma("unroll") for (int k = 0; k < 2; ++k) dst[m][k] = *(const PG8_LAS bf16x8*)(lds + PG8_SA(b, h) + aoff + m * 2048 + k * 1024); } while (0)
#define PG8_LDB(dst, b, h) do { _Pragma("unroll") for (int n = 0; n < 2; ++n) _Pragma("unroll") for (int k = 0; k < 2; ++k) dst[n][k] = *(const PG8_LAS bf16x8*)(lds + PG8_SB(b, h) + boff + n * 2048 + k * 1024); } while (0)
#define PG8_MMA(ai, bj, At, Bt) do { __builtin_amdgcn_s_setprio(1); _Pragma("unroll") for (int m = 0; m < 4; ++m) _Pragma("unroll") for (int n = 0; n < 2; ++n) _Pragma("unroll") for (int k = 0; k < 2; ++k) \
        acc[ai][bj][m][n] = __builtin_amdgcn_mfma_f32_16x16x32_bf16(Bt[n][k], At[m][k], acc[ai][bj][m][n], 0, 0, 0); __builtin_amdgcn_s_setprio(0); } while (0)
#define PG8_WAIT_V(n) asm volatile("s_waitcnt vmcnt(" #n ")" ::: "memory")
#define PG8_WAIT_L(n) asm volatile("s_waitcnt lgkmcnt(" #n ")" ::: "memory")
#define PG8_BAR __builtin_amdgcn_s_barrier()
#define PG8_SCHED __builtin_amdgcn_sched_barrier(0)
    Unit cur, nxt; int ui = 0;
    if (!S.next(0, cur)) return;
    f32x4 acc[2][2][4][2];
#pragma unroll
    for (int a = 0; a < 2; ++a)
#pragma unroll
        for (int b = 0; b < 2; ++b)
#pragma unroll
            for (int m = 0; m < 4; ++m)
#pragma unroll
                for (int n = 0; n < 2; ++n) acc[a][b][m][n] = (f32x4){0.f, 0.f, 0.f, 0.f};
    bf16x8 At[4][2], B0[2][2], B1[2][2];
    const char* cA = (const char*)g.A + (size_t)cur.pm * tstep; const char* cB = (const char*)g.Bt + (size_t)cur.pn * tstep;
    S.a_ready(cur);
    if constexpr (SP2) {
        PG8_STAGE(PG8_SB(0, 0), cB, voffB); PG8_STAGE(PG8_SB(0, 1), cB + hstep, voffB); PG8_STAGE(PG8_SA(0, 0), cA, voffA); PG8_STAGE(PG8_SA(0, 1), cA + hstep, voffA);
        if (wr == 1) PG8_BAR;
        PG8_WAIT_V(2); PG8_BAR;
        PG8_STAGE(PG8_SB(1, 0), cB + kstep, voffB); PG8_STAGE(PG8_SA(1, 0), cA + kstep, voffA); PG8_STAGE(PG8_SB(1, 1), cB + hstep + kstep, voffB);
        PG8_WAIT_V(6); PG8_BAR;
    } else {
        PG8_STAGE(PG8_SB(0, 0), cB, voffB); PG8_STAGE(PG8_SA(0, 0), cA, voffA); PG8_STAGE(PG8_SB(0, 1), cB + hstep, voffB); PG8_STAGE(PG8_SA(0, 1), cA + hstep, voffA);
        if (wr == 1) PG8_BAR;
        PG8_WAIT_V(4); PG8_BAR;
        PG8_STAGE(PG8_SB(1, 0), cB + kstep, voffB); PG8_STAGE(PG8_SA(1, 0), cA + kstep, voffA); PG8_STAGE(PG8_SB(1, 1), cB + hstep + kstep, voffB);
        PG8_WAIT_V(6); PG8_BAR;
    }
    for (;;) {
        const bool has_next = S.next(ui + 1, nxt);
        const char* nA = has_next ? (const char*)g.A + (size_t)nxt.pm * tstep : cA; const char* nB = has_next ? (const char*)g.Bt + (size_t)nxt.pn * tstep : cB;
        for (int t = 0; t < nt; t += 2) {
            const bool last = (t == nt - 2);
            const char* a1 = cA + (size_t)(t + 1) * kstep;
            const char* a2 = last ? nA : cA + (size_t)(t + 2) * kstep; const char* b2 = last ? nB : cB + (size_t)(t + 2) * kstep;
            const char* a3 = a2 + kstep; const char* b3 = b2 + kstep;
            if (last && has_next) S.a_ready(nxt);
            if constexpr (SP2) {
            PG8_LDB(B0, 0, 0); PG8_LDB(B1, 0, 1); PG8_SCHED; PG8_LDA(At, 0, 0); PG8_STAGE(PG8_SA(1, 1), a1 + hstep, voffA);
            PG8_WAIT_V(8); PG8_WAIT_L(0); PG8_BAR; PG8_MMA(0, 0, At, B0); PG8_MMA(0, 1, At, B1); PG8_BAR; PG8_SCHED;
            PG8_LDA(At, 0, 1); PG8_STAGE(PG8_SB(0, 0), b2, voffB); PG8_STAGE(PG8_SB(0, 1), b2 + hstep, voffB); PG8_STAGE(PG8_SA(0, 0), a2, voffA);
            PG8_WAIT_V(8); PG8_WAIT_L(0); PG8_BAR; PG8_MMA(1, 0, At, B0); PG8_MMA(1, 1, At, B1); PG8_BAR; PG8_SCHED;
            PG8_LDB(B0, 1, 0); PG8_LDB(B1, 1, 1); PG8_SCHED; PG8_LDA(At, 1, 0); PG8_STAGE(PG8_SA(0, 1), a2 + hstep, voffA);
            PG8_WAIT_V(8); PG8_WAIT_L(0); PG8_BAR; PG8_MMA(0, 0, At, B0); PG8_MMA(0, 1, At, B1); PG8_BAR; PG8_SCHED;
            PG8_LDA(At, 1, 1); PG8_STAGE(PG8_SB(1, 0), b3, voffB); PG8_STAGE(PG8_SB(1, 1), b3 + hstep, voffB); PG8_STAGE(PG8_SA(1, 0), a3, voffA);
            PG8_WAIT_V(8); PG8_WAIT_L(0); PG8_BAR; PG8_MMA(1, 0, At, B0); PG8_MMA(1, 1, At, B1); PG8_BAR; PG8_SCHED;
            } else {
            PG8_LDB(B0, 0, 0); PG8_SCHED; PG8_LDA(At, 0, 0); PG8_STAGE(PG8_SA(1, 1), a1 + hstep, voffA);
            PG8_WAIT_L(8); PG8_BAR; PG8_WAIT_L(0); PG8_MMA(0, 0, At, B0); PG8_BAR; PG8_SCHED;
            PG8_LDB(B1, 0, 1); PG8_STAGE(PG8_SB(0, 0), b2, voffB);
            PG8_BAR; PG8_WAIT_L(0); PG8_MMA(0, 1, At, B1); PG8_BAR;
            PG8_LDA(At, 0, 1); PG8_STAGE(PG8_SA(0, 0), a2, voffA);
            PG8_BAR; PG8_WAIT_L(0); PG8_MMA(1, 0, At, B0); PG8_BAR; PG8_SCHED;
            PG8_STAGE(PG8_SB(0, 1), b2 + hstep, voffB);
            PG8_WAIT_V(6); PG8_BAR; PG8_MMA(1, 1, At, B1); PG8_BAR;
            PG8_LDB(B0, 1, 0); PG8_SCHED; PG8_LDA(At, 1, 0); PG8_STAGE(PG8_SA(0, 1), a2 + hstep, voffA);
            PG8_WAIT_L(8); PG8_BAR; PG8_WAIT_L(0); PG8_MMA(0, 0, At, B0); PG8_BAR; PG8_SCHED;
            PG8_LDB(B1, 1, 1); PG8_STAGE(PG8_SB(1, 0), b3, voffB);
            PG8_BAR; PG8_WAIT_L(0); PG8_MMA(0, 1, At, B1); PG8_BAR;
            PG8_LDA(At, 1, 1); PG8_STAGE(PG8_SA(1, 0), a3, voffA);
            PG8_BAR; PG8_WAIT_L(0); PG8_MMA(1, 0, At, B0); PG8_BAR; PG8_SCHED;
            PG8_STAGE(PG8_SB(1, 1), b3 + hstep, voffB);
            PG8_WAIT_V(6); PG8_BAR; PG8_MMA(1, 1, At, B1); PG8_BAR;
            }
        }
        if constexpr (ALIGN_EPI) { if (wr == 0) PG8_BAR; }
        E(acc, cur, wr, wc, fr, fq); S.done(cur);
        if (!has_next) break;
#pragma unroll
        for (int a = 0; a < 2; ++a)
#pragma unroll
            for (int b = 0; b < 2; ++b)
#pragma unroll
                for (int m = 0; m < 4; ++m)
#pragma unroll
                    for (int n = 0; n < 2; ++n) acc[a][b][m][n] = (f32x4){0.f, 0.f, 0.f, 0.f};
        cur = nxt; cA = nA; cB = nB; ++ui;
        if constexpr (ALIGN_EPI) { if (wr == 1) PG8_BAR; }
    }
    PG8_WAIT_V(0);
    if constexpr (!ALIGN_EPI) { if (wr == 0) PG8_BAR; }
    PG8_BAR;
#undef PG8_SA
#undef PG8_SB
#undef PG8_STAGE
#undef PG8_LDA
#undef PG8_LDB
#undef PG8_MMA
#undef PG8_WAIT_V
#undef PG8_WAIT_L
#undef PG8_BAR
#undef PG8_SCHED
}
}

constexpr int NWAVES = 8;
constexpr int DM = 2048, NBATCH = 8, SEQ = 4096, MTOK = NBATCH * SEQ, DEPTH = 4, NA = 2;
constexpr int HG_H = 16, HG_D = 128;
constexpr int MLA_H = 16, NOPE = 128, ROPE = 64, VDIM = 128, QKD = 192, QLORA = 512, KVLORA = 512, CKVN = 768  ;
constexpr int DFF = 8192, NMOD = 6, MODW = NMOD * DM;
constexpr float EPS = 1e-6f;

constexpr size_t MiB = 1u << 20;
constexpr size_t WS_CTL = 0, CTL_ZERO_BYTES = 1 * MiB;
constexpr size_t WS_MOD = 1 * MiB;
constexpr size_t WS_KVMOD = WS_MOD + 1536 * 1024;
constexpr size_t WS_ROPE = 3 * MiB;
constexpr size_t WS_WIN = 16 * MiB;
constexpr size_t WS_WOUT = 80 * MiB;
constexpr size_t WS_W1 = 96 * MiB;
constexpr size_t WS_W2 = 224 * MiB;
constexpr size_t WS_WDKV = 352 * MiB;
constexpr size_t WS_WUKV = 355 * MiB;
constexpr size_t WS_WDQ = 359 * MiB;
constexpr size_t WS_WUQ = 363 * MiB;
constexpr size_t WS_WO = 369 * MiB;
constexpr size_t WS_H = 385 * MiB;
constexpr size_t WS_BIG = 513 * MiB;
constexpr size_t WS_KB = 1025 * MiB;
constexpr size_t WS_VB = 1217 * MiB;
constexpr size_t WS_END = 1345 * MiB;
constexpr size_t BIG_HKV = 0, BIG_KVRAW = 128 * MiB, BIG_CKV = 384 * MiB, BIG_CLAT = 480 * MiB;
constexpr size_t BIG_Q = 0, BIG_CQRAW = 192 * MiB, BIG_CQ = 256 * MiB;

constexpr int CW_TMO = 0, CW_CODE = 1, CW_BAR = 4096;

constexpr int RING_OFF = 0, RING_BYTES = 131072;
constexpr int LDSCTL_OFF = RING_BYTES, MISC_OFF = LDSCTL_OFF + 320;
constexpr int LDS_BYTES = 147456;

#define GAS __attribute__((address_space(1)))
#define LAS __attribute__((address_space(3)))
typedef unsigned short bf16;
typedef unsigned v4u __attribute__((ext_vector_type(4)));
typedef unsigned v2u __attribute__((ext_vector_type(2)));
typedef float f32x4 __attribute__((ext_vector_type(4)));
typedef float f32x2 __attribute__((ext_vector_type(2)));
typedef float f32x16 __attribute__((ext_vector_type(16)));
typedef short bf16x8 __attribute__((ext_vector_type(8)));
typedef short s16x4 __attribute__((ext_vector_type(4)));
typedef GAS unsigned gu32;
#define RLX_AGENT __ATOMIC_RELAXED, __HIP_MEMORY_SCOPE_AGENT
#define LDS_WAIT() asm volatile("s_waitcnt lgkmcnt(0)" ::: "memory")
#define VM_WAIT() asm volatile("s_waitcnt vmcnt(0)" ::: "memory")
__device__ __forceinline__ unsigned f2bf(float f) { unsigned u = __builtin_bit_cast(unsigned, f); return (u + 0x7fffu + ((u >> 16) & 1u)) >> 16; }
__device__ __forceinline__ unsigned pk2(float lo, float hi) { return f2bf(lo) | (f2bf(hi) << 16); }
__device__ __forceinline__ float bflo(unsigned w) { return __builtin_bit_cast(float, w << 16); }
__device__ __forceinline__ float bfhi(unsigned w) { return __builtin_bit_cast(float, w & 0xffff0000u); }

#define XB_TMO      128
#define XB_XCNT(j)  (256  + 64 * (j))
#define XB_XSUB(j)  (1280 + 64 * (j))
#define XB_XGEN(j)  (2304 + 64 * (j))
#define XB_TOP      3328
#define XB_TOPGEN   3392
#define XCD_BAR_WORDS 3456
#define XB_SPIN_CAP (1u << 22)

__device__ __forceinline__ unsigned xb_ld(unsigned* p)              { return __hip_atomic_load(p, __ATOMIC_RELAXED, __HIP_MEMORY_SCOPE_AGENT); }
__device__ __forceinline__ unsigned xb_add(unsigned* p, unsigned v) { return __hip_atomic_fetch_add(p, v, __ATOMIC_RELAXED, __HIP_MEMORY_SCOPE_AGENT); }
__device__ __forceinline__ unsigned xb_xcc_id() { return (unsigned)__builtin_amdgcn_s_getreg((3 << 11) | 20) & 0xFu; }
#define XB_SPIN(cond, bar) do { unsigned _sp = 0; while (cond) { __builtin_amdgcn_s_sleep(1); \
    if ((++_sp & 255u) == 0u) { if (xb_ld(&(bar)[XB_TMO])) break; if (_sp > XB_SPIN_CAP) { atomicAdd(&(bar)[XB_TMO], 1u); break; } } } } while (0)

struct XcdBarrier { unsigned* bar; unsigned x; volatile LAS unsigned* st; };

__device__ __forceinline__ XcdBarrier xcd_barrier_post(unsigned* bar, volatile LAS unsigned* st) {
    XcdBarrier b; b.bar = bar; b.x = xb_xcc_id(); b.st = st;
    if (threadIdx.x == 0) (void)xb_add(&bar[XB_XCNT(b.x)], 1u);
    return b;
}
__device__ __forceinline__ void xcd_barrier_complete(unsigned* bar, unsigned x, unsigned& nloc, unsigned& nx) {
    const unsigned G = gridDim.x * gridDim.y * gridDim.z;
    unsigned sum, cnt, mine, sp = 0u;
    for (;;) {
        sum = 0u; cnt = 0u; mine = 0u;
#pragma unroll
        for (unsigned j = 0; j < 16; ++j) { const unsigned c = xb_ld(&bar[XB_XCNT(j)]); sum += c; cnt += (c > 0u) ? 1u : 0u; mine = (j == x) ? c : mine; }
        if (sum == G) break;
        __builtin_amdgcn_s_sleep(1);
        if ((++sp & 255u) == 0u) { if (xb_ld(&bar[XB_TMO])) break; if (sp > XB_SPIN_CAP) { atomicAdd(&bar[XB_TMO], 1u); break; } }
    }
    nloc = mine > 0u ? mine : 1u; nx = cnt > 0u ? cnt : 1u;
}
__device__ __forceinline__ void xcd_barrier(const XcdBarrier& b) {
    asm volatile("s_waitcnt vmcnt(0)" ::: "memory");
    __syncthreads();
    if (threadIdx.x == 0) {
        unsigned* bar = b.bar;
        __builtin_amdgcn_s_waitcnt(0);
        unsigned nloc = b.st[0], nx = b.st[1];
        if (nloc == 0u) { xcd_barrier_complete(bar, b.x, nloc, nx); b.st[0] = nloc; b.st[1] = nx; }
        const unsigned old = xb_add(&bar[XB_XSUB(b.x)], 1u);
        const unsigned gen = old / nloc;
        if (old + 1u == (gen + 1u) * nloc) {
            __builtin_amdgcn_fence(__ATOMIC_RELEASE, "agent");
            asm volatile("s_waitcnt vmcnt(0)" ::: "memory");
            const unsigned og = xb_add(&bar[XB_TOP], 1u);
            const unsigned tg = og / nx;
            if (og + 1u == (tg + 1u) * nx) xb_add(&bar[XB_TOPGEN], 1u);
            else XB_SPIN(xb_ld(&bar[XB_TOPGEN]) == tg, bar);
            __builtin_amdgcn_fence(__ATOMIC_ACQUIRE, "agent");
            xb_add(&bar[XB_XGEN(b.x)], 1u);
            asm volatile("s_waitcnt vmcnt(0)" ::: "memory");
        } else {
            XB_SPIN(xb_ld(&bar[XB_XGEN(b.x)]) == gen, bar);
            __builtin_amdgcn_fence(__ATOMIC_ACQUIRE, "agent");
            asm volatile("s_waitcnt vmcnt(0)" ::: "memory");
        }
    }
    __syncthreads();
}

struct Args {
    const float* x; const float* c; const int* positions;
    const float* ada_w; const float* ada_b; const float* norm_mix; const float* norm_mlp;
    const float* mlp_w1; const float* mlp_w2; const float* hg_w_in; const float* hg_lower; const float* hg_o_norm; const float* hg_w_out;
    const float* kv_ada_w; const float* kv_ada_b; const float* kv_in_norm; const float* w_dkv; const float* kv_norm; const float* w_ukv; const float* k_norm;
    const float* w_dq; const float* q_lat_norm; const float* w_uq; const float* q_norm; const float* w_o;
    float* out; unsigned char* ws;
    int ph_lo, ph_hi;
};

struct Ctx { LAS unsigned char* lds; int tid, lane, wave, vcu, G; };
__device__ __forceinline__ Ctx fresh(const Ctx& C0) { Ctx C = C0; int t = threadIdx.x; asm volatile("" : "+v"(t)); C.tid = t; C.lane = t & 63; C.wave = __builtin_amdgcn_readfirstlane(t >> 6); return C; }

template <int MASK> __device__ __forceinline__ float xor_f(float v) {
    static_assert(MASK >= 1 && MASK <= 16, "xor_f: in-half masks only; use xor32 for the half exchange");
    return __int_as_float(__builtin_amdgcn_ds_swizzle(__float_as_int(v), (MASK << 10) | 0x1f));
}
__device__ __forceinline__ float xor32(float v, int lane) {
    auto rr = __builtin_amdgcn_permlane32_swap(__float_as_uint(v), __float_as_uint(v), false, false); return lane < 32 ? __uint_as_float(rr[1]) : __uint_as_float(rr[0]);
}
__device__ __forceinline__ float wave_sum(float v) {
    v += xor_f<1>(v); v += xor_f<2>(v); v += xor_f<4>(v); v += xor_f<8>(v); v += xor_f<16>(v);
    { auto rr = __builtin_amdgcn_permlane32_swap(__float_as_uint(v), __float_as_uint(v), false, false); v = __uint_as_float(rr[0]) + __uint_as_float(rr[1]); }
    return v;
}

__device__ __forceinline__ void p0_transpose_item(const float* W, int K, int N, bf16* WT, LAS float* scr, int item, int lane) {
    const int nblk = N / 32, kb = item / nblk, nb = item % nblk, k0 = 64 * kb, n0 = 32 * nb;
#pragma unroll 8
    for (int i = 0; i < 32; ++i) { const int kk = 2 * i + (lane >> 5); scr[kk * 33 + (lane & 31)] = W[(size_t)(k0 + kk) * N + n0 + (lane & 31)]; }
    LDS_WAIT(); asm volatile("" ::: "memory");
    const int c = lane & 7;
#pragma unroll
    for (int j = 0; j < 4; ++j) { const int n = (lane >> 3) + 8 * j; const LAS float* s = scr + (8 * c) * 33 + n;
        v4u o; o.x = pk2(s[0 * 33], s[1 * 33]); o.y = pk2(s[2 * 33], s[3 * 33]); o.z = pk2(s[4 * 33], s[5 * 33]); o.w = pk2(s[6 * 33], s[7 * 33]);
        *(GAS v4u*)(WT + (size_t)(n0 + n) * K + k0 + 8 * c) = o; }
    LDS_WAIT(); asm volatile("" ::: "memory");
}

__device__ __forceinline__ void phase_prologue(const Args& a, const Ctx& C) {
    unsigned char* ws = a.ws;
    {
        LAS float* scr = (LAS float*)(C.lds + RING_OFF + C.wave * 16384);
        const int gw = C.vcu * NWAVES + C.wave, NGW = C.G * NWAVES;
        constexpr int I_IN = (DM / 64) * (4 * DM / 32), I_SQ = (DM / 64) * (DM / 32), I_W1 = (DM / 64) * (DFF / 32), I_W2 = (DFF / 64) * (DM / 32);
        constexpr int I_DKV = (DM / 64) * (576 / 32), I_UKV = (KVLORA / 64) * (4096 / 32), I_DQ = (DM / 64) * (QLORA / 32), I_UQ = (QLORA / 64) * (3072 / 32);
        constexpr int NITEMS = 2 * I_IN + 2 * I_SQ + 4 * I_W1 + 4 * I_W2 + I_DKV + I_UKV + 2 * I_DQ + 2 * I_UQ + 2 * I_SQ;
        for (int it = gw; it < NITEMS; it += NGW) {
            int r = it;
            if (r < 2 * I_IN) { const int l = r / I_IN; p0_transpose_item(a.hg_w_in + (size_t)l * DM * 4 * DM, DM, 4 * DM, (bf16*)(ws + WS_WIN) + (size_t)l * 4 * DM * DM, scr, r % I_IN, C.lane); continue; } r -= 2 * I_IN;
            if (r < 2 * I_SQ) { const int l = r / I_SQ; p0_transpose_item(a.hg_w_out + (size_t)l * DM * DM, DM, DM, (bf16*)(ws + WS_WOUT) + (size_t)l * DM * DM, scr, r % I_SQ, C.lane); continue; } r -= 2 * I_SQ;
            if (r < 4 * I_W1) { const int l = r / I_W1; p0_transpose_item(a.mlp_w1 + (size_t)l * DM * DFF, DM, DFF, (bf16*)(ws + WS_W1) + (size_t)l * DM * DFF, scr, r % I_W1, C.lane); continue; } r -= 4 * I_W1;
            if (r < 4 * I_W2) { const int l = r / I_W2; p0_transpose_item(a.mlp_w2 + (size_t)l * DM * DFF, DFF, DM, (bf16*)(ws + WS_W2) + (size_t)l * DM * DFF, scr, r % I_W2, C.lane); continue; } r -= 4 * I_W2;
            if (r < I_DKV) { p0_transpose_item(a.w_dkv, DM, 576, (bf16*)(ws + WS_WDKV), scr, r, C.lane); continue; } r -= I_DKV;
            if (r < I_UKV) { p0_transpose_item(a.w_ukv, KVLORA, 4096, (bf16*)(ws + WS_WUKV), scr, r, C.lane); continue; } r -= I_UKV;
            if (r < 2 * I_DQ) { const int l = r / I_DQ; p0_transpose_item(a.w_dq + (size_t)l * DM * QLORA, DM, QLORA, (bf16*)(ws + WS_WDQ) + (size_t)l * DM * QLORA, scr, r % I_DQ, C.lane); continue; } r -= 2 * I_DQ;
            if (r < 2 * I_UQ) { const int l = r / I_UQ; p0_transpose_item(a.w_uq + (size_t)l * QLORA * 3072, QLORA, 3072, (bf16*)(ws + WS_WUQ) + (size_t)l * QLORA * 3072, scr, r % I_UQ, C.lane); continue; } r -= 2 * I_UQ;
            { const int l = r / I_SQ; p0_transpose_item(a.w_o + (size_t)l * DM * DM, DM, DM, (bf16*)(ws + WS_WO) + (size_t)l * DM * DM, scr, r % I_SQ, C.lane); }
        }
        { v4u z = {0u, 0u, 0u, 0u}; GAS v4u* p = (GAS v4u*)((bf16*)(ws + WS_WDKV) + (size_t)576 * DM); const int n16 = (768 - 576) * DM * 2 / 16;
          for (int i = C.vcu * 512 + C.tid; i < n16; i += C.G * 512) p[i] = z; }
    }
    {
        GAS f32x2* tab = (GAS f32x2*)(ws + WS_ROPE);
        for (int idx = C.vcu * 512 + C.tid; idx < MTOK * 32; idx += C.G * 512) {
            const int m = idx >> 5, i = idx & 31;
            const float inv = exp2f(-(float)i * 0.41524101186092029f);
            const float ang = (float)a.positions[m] * inv;
            const float n = rintf(ang * 0.15915494309189535f);
            float r = fmaf(-n, 6.2831854820251465f, ang); r = fmaf(-n, -1.7484555e-7f, r);
            tab[idx] = (f32x2){__cosf(r), __sinf(r)};
        }
    }
    __syncthreads();
    {
        LAS float* cs = (LAS float*)(C.lds + RING_OFF);
        LAS float* red = (LAS float*)(C.lds + RING_OFF + 65536);
        for (int i = C.tid; i < NBATCH * DM; i += 512) { const int b = i >> 11, k = i & 2047; const float v = a.c[i]; cs[k * 8 + b] = v / (1.0f + __expf(-v)); }
        __syncthreads();
        constexpr int U_ADA = DEPTH * MODW / 256, U_KV = 2 * DM / 256;
        for (int u = C.vcu; u < U_ADA + U_KV; u += C.G) {
            const float* W; const float* bias; float* outp; int N, n0;
            if (u < U_ADA) { const int l = u / (MODW / 256); n0 = (u % (MODW / 256)) * 256; N = MODW; W = a.ada_w + (size_t)l * DM * MODW; bias = a.ada_b + (size_t)l * MODW; outp = (float*)(ws + WS_MOD) + (size_t)l * NBATCH * MODW; }
            else { n0 = (u - U_ADA) * 256; N = 2 * DM; W = a.kv_ada_w; bias = a.kv_ada_b; outp = (float*)(ws + WS_KVMOD); }
            f32x4 acc[8];
#pragma unroll
            for (int b = 0; b < 8; ++b) acc[b] = (f32x4){0.f, 0.f, 0.f, 0.f};
            const float* wp = W + (size_t)(C.wave * 256) * N + n0 + 4 * C.lane;
#pragma unroll 4
            for (int k = 0; k < 256; ++k) {
                const f32x4 w4 = *(const f32x4*)(wp + (size_t)k * N);
                const f32x4 c0 = *(const LAS f32x4*)(cs + (C.wave * 256 + k) * 8), c1 = *(const LAS f32x4*)(cs + (C.wave * 256 + k) * 8 + 4);
                acc[0] += w4 * c0[0]; acc[1] += w4 * c0[1]; acc[2] += w4 * c0[2]; acc[3] += w4 * c0[3];
                acc[4] += w4 * c1[0]; acc[5] += w4 * c1[1]; acc[6] += w4 * c1[2]; acc[7] += w4 * c1[3];
            }
#pragma unroll
            for (int b = 0; b < 8; ++b) *(LAS f32x4*)(red + (C.wave * 8 + b) * 256 + 4 * C.lane) = acc[b];
            __syncthreads();
            { const int b = C.tid >> 6, cl = 4 * (C.tid & 63); f32x4 s = *(const f32x4*)(bias + n0 + cl);
#pragma unroll
              for (int w = 0; w < 8; ++w) s += *(const LAS f32x4*)(red + (w * 8 + b) * 256 + cl);
              *(f32x4*)(outp + (size_t)b * N + n0 + cl) = s; }
            __syncthreads();
        }
    }
}

template <bool DUAL>
__device__ __forceinline__ void phase_norm_mod(const Ctx& C, const float* xin, const float* g1, const float* sh1, const float* sc1, int mstride1, bf16* o1,
                                               const float* g2, const float* sh2, const float* sc2, int mstride2, bf16* o2) {
    const int gw = C.vcu * NWAVES + C.wave, NGW = C.G * NWAVES;
    for (int m = gw; m < MTOK; m += NGW) {
        const int b = m >> 12;
        const f32x4* xr = (const f32x4*)(xin + (size_t)m * DM) + C.lane;
        f32x4 v[8]; float s = 0.f;
#pragma unroll
        for (int j = 0; j < 8; ++j) { v[j] = xr[64 * j]; s += (v[j].x * v[j].x + v[j].y * v[j].y) + (v[j].z * v[j].z + v[j].w * v[j].w); }
        const float rstd = 1.0f / sqrtf(wave_sum(s) * (1.0f / DM) + EPS);
#pragma unroll
        for (int j = 0; j < 8; ++j) {
            const int col = 4 * (C.lane + 64 * j);
            const f32x4 y = v[j] * rstd;
            { const f32x4 g = *(const f32x4*)(g1 + col), sh = *(const f32x4*)(sh1 + (size_t)b * mstride1 + col), sc = *(const f32x4*)(sc1 + (size_t)b * mstride1 + col);
              const f32x4 h = (y * g) * (sc + 1.0f) + sh; v2u w; w.x = pk2(h.x, h.y); w.y = pk2(h.z, h.w); *(GAS v2u*)(o1 + (size_t)m * DM + col) = w; }
            if (DUAL) { const f32x4 g = *(const f32x4*)(g2 + col), sh = *(const f32x4*)(sh2 + (size_t)b * mstride2 + col), sc = *(const f32x4*)(sc2 + (size_t)b * mstride2 + col);
              const f32x4 h = (y * g) * (sc + 1.0f) + sh; v2u w; w.x = pk2(h.x, h.y); w.y = pk2(h.z, h.w); *(GAS v2u*)(o2 + (size_t)m * DM + col) = w; }
        }
    }
}
__device__ __forceinline__ void phase_rms512(const Ctx& C, const float* src, int ld, const float* gain, bf16* out) {
    const int gw = C.vcu * NWAVES + C.wave, NGW = C.G * NWAVES;
    const f32x4 g0 = *(const f32x4*)(gain + 4 * C.lane), g1 = *(const f32x4*)(gain + 256 + 4 * C.lane);
    for (int m = gw; m < MTOK; m += NGW) {
        const f32x4* r = (const f32x4*)(src + (size_t)m * ld) + C.lane;
        const f32x4 v0 = r[0], v1 = r[64];
        const float s = (v0.x * v0.x + v0.y * v0.y) + (v0.z * v0.z + v0.w * v0.w) + (v1.x * v1.x + v1.y * v1.y) + (v1.z * v1.z + v1.w * v1.w);
        const float rstd = 1.0f / sqrtf(wave_sum(s) * (1.0f / 512.0f) + EPS);
        const f32x4 a = v0 * rstd * g0, b = v1 * rstd * g1;
        v2u w0, w1; w0.x = pk2(a.x, a.y); w0.y = pk2(a.z, a.w); w1.x = pk2(b.x, b.y); w1.y = pk2(b.z, b.w);
        *(GAS v2u*)(out + (size_t)m * 512 + 4 * C.lane) = w0; *(GAS v2u*)(out + (size_t)m * 512 + 256 + 4 * C.lane) = w1;
    }
}
__device__ __forceinline__ void phase_kv_build(const Ctx& C, const bf16* kvraw, const float* ckv, const float* kgain, const f32x2* rope, bf16* Kb, bf16* Vb) {
    const int gw = C.vcu * NWAVES + C.wave, NGW = C.G * NWAVES, lane = C.lane;
    const float kg0 = kgain[2 * lane], kg1 = kgain[2 * lane + 1], kgp = kgain[128 + lane];
    for (int m = gw; m < MTOK; m += NGW) {
        const int b = m >> 12, s = m & 4095;
        const float pe = ckv[(size_t)m * CKVN + 512 + lane];
        const float pss = wave_sum(pe * pe);
        const f32x2 cs = rope[(size_t)m * 32 + (lane & 31)];
        const unsigned* kr = (const unsigned*)(kvraw + (size_t)m * 4096);
#pragma unroll 4
        for (int h = 0; h < MLA_H; ++h) {
            const unsigned w = kr[h * 128 + lane], wv = kr[h * 128 + 64 + lane];
            const float k0 = bflo(w), k1 = bfhi(w);
            const float rstd = 1.0f / sqrtf((wave_sum(k0 * k0 + k1 * k1) + pss) * (1.0f / 192.0f) + EPS);
            bf16* ko = Kb + ((size_t)(b * MLA_H + h) * SEQ + s) * QKD;
            *(GAS unsigned*)(ko + 2 * lane) = pk2(k0 * rstd * kg0, k1 * rstd * kg1);
            const float pn = pe * rstd * kgp, other = xor32(pn, lane);
            const float ro = lane < 32 ? pn * cs.x - other * cs.y : pn * cs.x + other * cs.y;
            *(GAS unsigned short*)(ko + 128 + lane) = (unsigned short)f2bf(ro);
            *(GAS unsigned*)(Vb + ((size_t)(b * MLA_H + h) * SEQ + s) * VDIM + 2 * lane) = wv;
        }
    }
}
__device__ __forceinline__ void phase_q_post(const Ctx& C, bf16* Q, const float* qgain, const f32x2* rope) {
    const int gw = C.vcu * NWAVES + C.wave, NGW = C.G * NWAVES, lane = C.lane;
    const float g0 = qgain[2 * lane], g1 = qgain[2 * lane + 1], gp = qgain[128 + lane];
    for (int m = gw; m < MTOK; m += NGW) {
        const f32x2 cs = rope[(size_t)m * 32 + (lane & 31)];
        bf16* qr = Q + (size_t)m * 3072;
#pragma unroll 4
        for (int h = 0; h < MLA_H; ++h) {
            bf16* qh = qr + h * QKD;
            const unsigned w = *(const GAS unsigned*)(qh + 2 * lane); const float pe = bflo((unsigned)*(const GAS unsigned short*)(qh + 128 + lane));
            const float q0 = bflo(w), q1 = bfhi(w);
            const float rstd = 1.0f / sqrtf(wave_sum(q0 * q0 + q1 * q1 + pe * pe) * (1.0f / 192.0f) + EPS);
            *(GAS unsigned*)(qh + 2 * lane) = pk2(q0 * rstd * g0, q1 * rstd * g1);
            const float pn = pe * rstd * gp, other = xor32(pn, lane);
            const float ro = lane < 32 ? pn * cs.x - other * cs.y : pn * cs.x + other * cs.y;
            *(GAS unsigned short*)(qh + 128 + lane) = (unsigned short)f2bf(ro);
        }
    }
}

__device__ __forceinline__ void phase_hgrn_simple(const Ctx& C, const Args& a, int layer, const bf16* proj, bf16* Hout) {
    LAS float* fA = (LAS float*)(C.lds + RING_OFF);
    LAS float* kA = fA + 32 * 128; LAS float* qA = kA + 32 * 128; LAS float* vA = qA + 32 * 128; LAS float* oA = vA + 32 * 128;
    const int tid = C.tid, st = tid >> 4, sc8 = (tid & 15) * 8, j = tid >> 2, qd = tid & 3;
    for (int unit = C.vcu; unit < NBATCH * HG_H; unit += C.G) {
        const int b = unit >> 4, h = unit & 15;
        float lb[8], og[8];
#pragma unroll
        for (int e = 0; e < 8; ++e) { const int c = h * 128 + sc8 + e; const float a0 = a.hg_lower[c], a1 = a.hg_lower[DM + c], a2 = a.hg_lower[2 * DM + c];
            const float mx = fmaxf(a0, fmaxf(a1, a2)), e0 = expf(a0 - mx), e1 = expf(a1 - mx), e2 = expf(a2 - mx), inv = 1.0f / (e0 + e1 + e2);
            lb[e] = (layer == 0) ? e0 * inv : (e0 + e1) * inv; og[e] = a.hg_o_norm[layer * HG_D + sc8 + e]; }
        float S[32];
#pragma unroll
        for (int i = 0; i < 32; ++i) S[i] = 0.f;
        for (int c0 = 0; c0 < SEQ; c0 += 32) {
            const size_t row = (size_t)b * SEQ + c0 + st;
            const bf16* pr = proj + row * (4 * DM) + h * 128 + sc8;
            const v4u q8 = *(const GAS v4u*)pr, z8 = *(const GAS v4u*)(pr + DM), v8 = *(const GAS v4u*)(pr + 2 * DM);
            {
                float qf[8], zf[8], vf[8];
#pragma unroll
                for (int e = 0; e < 4; ++e) { qf[2 * e] = bflo(q8[e]); qf[2 * e + 1] = bfhi(q8[e]); zf[2 * e] = bflo(z8[e]); zf[2 * e + 1] = bfhi(z8[e]); vf[2 * e] = bflo(v8[e]); vf[2 * e + 1] = bfhi(v8[e]); }
                float ff[8], kf[8];
#pragma unroll
                for (int e = 0; e < 8; ++e) { const float sg = 1.0f / (1.0f + __expf(-zf[e])); ff[e] = lb[e] + (1.0f - lb[e]) * sg; kf[e] = (1.0f - lb[e]) * (1.0f - sg); qf[e] *= 0.08838834764831845f; }
                const int o = st * 128 + sc8;
                *(LAS f32x4*)(fA + o) = (f32x4){ff[0], ff[1], ff[2], ff[3]}; *(LAS f32x4*)(fA + o + 4) = (f32x4){ff[4], ff[5], ff[6], ff[7]};
                *(LAS f32x4*)(kA + o) = (f32x4){kf[0], kf[1], kf[2], kf[3]}; *(LAS f32x4*)(kA + o + 4) = (f32x4){kf[4], kf[5], kf[6], kf[7]};
                *(LAS f32x4*)(qA + o) = (f32x4){qf[0], qf[1], qf[2], qf[3]}; *(LAS f32x4*)(qA + o + 4) = (f32x4){qf[4], qf[5], qf[6], qf[7]};
                *(LAS f32x4*)(vA + o) = (f32x4){vf[0], vf[1], vf[2], vf[3]}; *(LAS f32x4*)(vA + o + 4) = (f32x4){vf[4], vf[5], vf[6], vf[7]};
            }
            __syncthreads();
            for (int t = 0; t < 32; ++t) {
                const float vj = vA[t * 128 + j];
                float part = 0.f;
#pragma unroll
                for (int i4 = 0; i4 < 8; ++i4) {
                    const f32x4 f4 = *(const LAS f32x4*)(fA + t * 128 + qd * 32 + i4 * 4), k4 = *(const LAS f32x4*)(kA + t * 128 + qd * 32 + i4 * 4), q4 = *(const LAS f32x4*)(qA + t * 128 + qd * 32 + i4 * 4);
#pragma unroll
                    for (int e = 0; e < 4; ++e) { S[i4 * 4 + e] = fmaf(f4[e], S[i4 * 4 + e], k4[e] * vj); part = fmaf(q4[e], S[i4 * 4 + e], part); }
                }
                part += xor_f<1>(part); part += xor_f<2>(part);
                if (qd == 0) oA[t * 128 + j] = part;
            }
            __syncthreads();
            {
                const f32x4 o0 = *(const LAS f32x4*)(oA + st * 128 + sc8), o1 = *(const LAS f32x4*)(oA + st * 128 + sc8 + 4);
                float ss = (o0.x * o0.x + o0.y * o0.y) + (o0.z * o0.z + o0.w * o0.w) + (o1.x * o1.x + o1.y * o1.y) + (o1.z * o1.z + o1.w * o1.w);
                ss += xor_f<1>(ss); ss += xor_f<2>(ss); ss += xor_f<4>(ss); ss += xor_f<8>(ss);
                const float rstd = 1.0f / sqrtf(ss * (1.0f / 128.0f) + EPS);
                const v4u g8 = *(const GAS v4u*)(pr + 3 * DM);
                const float ov[8] = {o0.x, o0.y, o0.z, o0.w, o1.x, o1.y, o1.z, o1.w};
                float r[8];
#pragma unroll
                for (int e = 0; e < 8; ++e) { const float g = (e & 1) ? bfhi(g8[e >> 1]) : bflo(g8[e >> 1]); const float sl = g / (1.0f + __expf(-g));
                    r[e] = ov[e] * rstd * og[e] * sl; }
                v4u w; w.x = pk2(r[0], r[1]); w.y = pk2(r[2], r[3]); w.z = pk2(r[4], r[5]); w.w = pk2(r[6], r[7]);
                *(GAS v4u*)(Hout + row * DM + h * 128 + sc8) = w;
            }
        }
        __syncthreads();
    }
}

namespace att {
constexpr int KROW = 400;
constexpr int SHM_K = 64 * KROW;
constexpr int SHM_V = 64 * 128 * 2;
constexpr int V_OFF = 0, K_OFF = 2 * SHM_V, WS_OFF = K_OFF + 2 * SHM_K;
constexpr float SCALE = 0.07216878364870322f;
constexpr float THR = 8.f;
#define SBAR() __builtin_amdgcn_sched_barrier(0)
__device__ __forceinline__ int v_st(int k, int c) { const int kk = (k & ~0xC) | ((k & 4) << 1) | ((k & 8) >> 1); return ((kk >> 3) * 4 + (c >> 5)) * 512 + ((kk & 7) * 32 + (c & 31)) * 2; }
__device__ __forceinline__ int v_rd_base(int lane) { return ((lane & 3) << 3) | (((lane >> 2) & 3) << 6) | (((lane >> 4) & 1) << 5) | (((lane >> 5) & 1) << 8); }
constexpr int v_rd_off(int d0, int ks, int half) { return d0 * 512 + ks * 4096 + half * 2048; }
__device__ __forceinline__ int crow(int r, int hi) { return (r & 3) + 8 * (r >> 2) + 4 * hi; }
__device__ __forceinline__ unsigned cvtpk(float lo, float hi) { unsigned r; asm volatile("v_cvt_pk_bf16_f32 %0, %1, %2" : "=v"(r) : "v"(lo), "v"(hi)); return r; }

__device__ __forceinline__ void mask_tile(f32x16& p0, f32x16& p1, int dq) {
    const float NEG = -__builtin_inff();
#pragma unroll
    for (int r = 0; r < 16; ++r) {
        const int c = (r & 3) + 8 * (r >> 2);
        if (dq - c < 0) p0[r] = NEG;
        if (dq - c - 32 < 0) p1[r] = NEG;
    }
}
__device__ __forceinline__ void partialSM(f32x16& p0, f32x16& p1, float& m_reg, float& mn, float& alpha) {
    float pmax = p0[0];
#pragma unroll
    for (int r = 1; r < 16; ++r) pmax = fmaxf(pmax, p0[r]);
#pragma unroll
    for (int r = 0; r < 16; ++r) pmax = fmaxf(pmax, p1[r]);
    { auto rr = __builtin_amdgcn_permlane32_swap(__float_as_uint(pmax), __float_as_uint(pmax), false, false);
      pmax = fmaxf(__uint_as_float(rr[0]), __uint_as_float(rr[1])); }
    constexpr float C2 = 1.4426950408889634f * SCALE;
    if (__builtin_expect(__all((pmax - m_reg) * SCALE <= THR), 1)) { mn = m_reg; alpha = 1.f; }
    else { mn = fmaxf(m_reg, pmax); alpha = __builtin_amdgcn_exp2f((m_reg - mn) * C2); m_reg = mn; }
    const float mnL = -mn * C2;
#pragma unroll
    for (int r = 0; r < 16; ++r) p0[r] = fmaf(p0[r], C2, mnL);
#pragma unroll
    for (int r = 0; r < 16; ++r) p1[r] = fmaf(p1[r], C2, mnL);
#pragma unroll
    for (int r = 0; r < 16; ++r) p0[r] = __builtin_amdgcn_exp2f(p0[r]);
}
__device__ __forceinline__ void finishSM(f32x16& p0, f32x16& p1, float alpha, float& l_reg, bf16x8& pa0, bf16x8& pa1, bf16x8& pa2, bf16x8& pa3) {
#pragma unroll
    for (int r = 0; r < 16; ++r) p1[r] = __builtin_amdgcn_exp2f(p1[r]);
    float ps = 0;
#pragma unroll
    for (int r = 0; r < 16; ++r) ps += p0[r];
#pragma unroll
    for (int r = 0; r < 16; ++r) ps += p1[r];
    { auto rr = __builtin_amdgcn_permlane32_swap(__float_as_uint(ps), __float_as_uint(ps), false, false);
      ps = __uint_as_float(rr[0]) + __uint_as_float(rr[1]); }
    l_reg = l_reg * alpha + ps;
#define PK4(P, B_, OUT) do { unsigned a0 = cvtpk(P[B_+0], P[B_+1]), a1 = cvtpk(P[B_+2], P[B_+3]);                          \
        unsigned b0 = cvtpk(P[B_+4], P[B_+5]), b1 = cvtpk(P[B_+6], P[B_+7]);                                             \
        auto r0 = __builtin_amdgcn_permlane32_swap(a0, b0, false, false); auto r1 = __builtin_amdgcn_permlane32_swap(a1, b1, false, false); \
        v4u w = {r0[0], r1[0], r0[1], r1[1]}; OUT = __builtin_bit_cast(bf16x8, w); } while (0)
    PK4(p0, 0, pa0); PK4(p0, 8, pa1); PK4(p1, 0, pa2); PK4(p1, 8, pa3);
#undef PK4
}
template <int KB>
__device__ __forceinline__ void qkt(f32x16& p0, f32x16& p1, const LAS char* lds, int kbase, const bf16x8* qr) {
#pragma unroll
    for (int r = 0; r < 16; ++r) { p0[r] = 0.f; p1[r] = 0.f; }
    const LAS char* a = lds + K_OFF + KB * SHM_K + kbase;
#pragma unroll
    for (int d0 = 0; d0 < 12; ++d0) {
        const bf16x8 b0 = *(const LAS bf16x8*)(a + d0 * 32);
        const bf16x8 b1 = *(const LAS bf16x8*)(a + d0 * 32 + 32 * KROW);
        p0 = __builtin_amdgcn_mfma_f32_32x32x16_bf16(b0, qr[d0], p0, 0, 0, 0);
        p1 = __builtin_amdgcn_mfma_f32_32x32x16_bf16(b1, qr[d0], p1, 0, 0, 0); }
}
template <int VB>
__device__ __forceinline__ void pv_tile(f32x16* o, int vb0, bf16x8 pa0, bf16x8 pa1, bf16x8 pa2, bf16x8 pa3) {
#define TRRD(dst, off) asm volatile("ds_read_b64_tr_b16 %0, %1 offset:%2" : "=&v"(dst) : "v"(vb0), "i"(off) : "memory")
#define PV_D0(d0) do { s16x4 l0, l1, l2, l3, h0, h1, h2, h3; constexpr int b_ = V_OFF + VB * SHM_V + v_rd_off(d0, 0, 0); \
        TRRD(l0, b_); TRRD(h0, b_ + 2048); TRRD(l1, b_ + 4096); TRRD(h1, b_ + 6144); TRRD(l2, b_ + 8192); TRRD(h2, b_ + 10240); TRRD(l3, b_ + 12288); TRRD(h3, b_ + 14336); \
        asm volatile("s_waitcnt lgkmcnt(0)" ::: "memory"); SBAR();   \
        o[d0] = __builtin_amdgcn_mfma_f32_32x32x16_bf16(pa0, (bf16x8){l0[0], l0[1], l0[2], l0[3], h0[0], h0[1], h0[2], h0[3]}, o[d0], 0, 0, 0);   \
        o[d0] = __builtin_amdgcn_mfma_f32_32x32x16_bf16(pa1, (bf16x8){l1[0], l1[1], l1[2], l1[3], h1[0], h1[1], h1[2], h1[3]}, o[d0], 0, 0, 0);   \
        o[d0] = __builtin_amdgcn_mfma_f32_32x32x16_bf16(pa2, (bf16x8){l2[0], l2[1], l2[2], l2[3], h2[0], h2[1], h2[2], h2[3]}, o[d0], 0, 0, 0);   \
        o[d0] = __builtin_amdgcn_mfma_f32_32x32x16_bf16(pa3, (bf16x8){l3[0], l3[1], l3[2], l3[3], h3[0], h3[1], h3[2], h3[3]}, o[d0], 0, 0, 0); } while (0)
    PV_D0(0); PV_D0(1); PV_D0(2); PV_D0(3);
#undef PV_D0
#undef TRRD
}

__device__ __forceinline__ void attn_block(const Ctx& C, int b, int h, int qb, const bf16* Q, const bf16* Kb, const bf16* Vb, bf16* O) {
    const int tid = C.tid, wid = C.wave, lane = C.lane, r32 = lane & 31, hi = lane >> 5;
    const LAS char* lds = (const LAS char*)C.lds;
    LAS char* ldsw = (LAS char*)C.lds;
    const int P0 = qb * 256, qlo = P0 + wid * 32, NT = (P0 + 256) / 64;
    const bf16* Kh = Kb + (size_t)(b * MLA_H + h) * SEQ * QKD;
    const bf16* Vh = Vb + (size_t)(b * MLA_H + h) * SEQ * VDIM;
    bf16x8 qr[12];
    { const bf16* qp = Q + (size_t)(b * SEQ + qlo + r32) * 3072 + h * QKD + hi * 8;
#pragma unroll
      for (int d0 = 0; d0 < 12; ++d0) qr[d0] = *(const GAS bf16x8*)(qp + d0 * 16); }
    LAS float* wsf = (LAS float*)(ldsw + WS_OFF) + wid * 64; LAS float* li_l = wsf; LAS float* al_l = wsf + 32;
    float m_reg = -1e30f, l_reg = 0.f; f32x16 o[4];
#pragma unroll
    for (int d = 0; d < 4; ++d)
#pragma unroll
        for (int r = 0; r < 16; ++r) o[d][r] = 0.f;
    int kdst[3];
#pragma unroll
    for (int i = 0; i < 3; ++i) { const int c = tid + 512 * i; kdst[i] = (c / 24) * KROW + (c % 24) * 16; }
    const int sr = tid >> 4, sc = (tid & 15) * 8, vst0 = v_st(sr, sc), vst1 = v_st(32 + sr, sc);
    const int kbase = r32 * KROW + hi * 16;
    const int vb0 = (int)(unsigned)(uintptr_t)(ldsw) + v_rd_base(lane);
    const int qm = qlo + r32 - 4 * hi;
    bf16x8 sk0, sk1, sk2, sv0, sv1;
#define A_LOAD(t) do { const bf16* kp = Kh + (size_t)(t) * 64 * QKD + tid * 8; sk0 = *(const GAS bf16x8*)kp; sk1 = *(const GAS bf16x8*)(kp + 4096); sk2 = *(const GAS bf16x8*)(kp + 8192); \
        const bf16* vp = Vh + (size_t)((t) * 64 + sr) * VDIM + sc; sv0 = *(const GAS bf16x8*)vp; sv1 = *(const GAS bf16x8*)(vp + 32 * VDIM); } while (0)
#define A_WRITE(bf) do { *(LAS bf16x8*)(ldsw + K_OFF + (bf) * SHM_K + kdst[0]) = sk0; *(LAS bf16x8*)(ldsw + K_OFF + (bf) * SHM_K + kdst[1]) = sk1; *(LAS bf16x8*)(ldsw + K_OFF + (bf) * SHM_K + kdst[2]) = sk2; \
        *(LAS bf16x8*)(ldsw + V_OFF + (bf) * SHM_V + vst0) = sv0; *(LAS bf16x8*)(ldsw + V_OFF + (bf) * SHM_V + vst1) = sv1; } while (0)
#define RESC(aa) do { if (__any((aa) < 1.f)) { if (hi == 0) al_l[r32] = (aa); asm volatile("s_waitcnt lgkmcnt(0)" ::: "memory");              \
        _Pragma("unroll") for (int d_ = 0; d_ < 4; ++d_) _Pragma("unroll") for (int r = 0; r < 16; ++r) o[d_][r] *= al_l[crow(r, hi)]; } } while (0)
#define A_COMPUTE(t, BF) do { const int kb_ = (t) * 64; if (kb_ <= qlo + 31) { f32x16 p0, p1; float mn, al; bf16x8 pa0, pa1, pa2, pa3;   \
        qkt<BF>(p0, p1, lds, kbase, qr);                                              \
        if (kb_ + 63 > qlo) mask_tile(p0, p1, qm - kb_);                               \
        partialSM(p0, p1, m_reg, mn, al); finishSM(p0, p1, al, l_reg, pa0, pa1, pa2, pa3); RESC(al); SBAR();  \
        pv_tile<BF>(o, vb0, pa0, pa1, pa2, pa3); } } while (0)
    A_LOAD(0); VM_WAIT(); A_WRITE(0); __syncthreads();
    for (int t = 0; t < NT; t += 2) {
        A_LOAD(t + 1);
        A_COMPUTE(t, 0);
        VM_WAIT(); A_WRITE(1); __syncthreads();
        if (t + 2 < NT) A_LOAD(t + 2);
        A_COMPUTE(t + 1, 1);
        if (t + 2 < NT) { VM_WAIT(); A_WRITE(0); }
        __syncthreads();
    }
    if (hi == 0) li_l[r32] = l_reg;
    asm volatile("s_waitcnt lgkmcnt(0)" ::: "memory");
    int hi_e = hi, r32_e = r32; asm volatile("" : "+v"(hi_e), "+v"(r32_e));
    bf16* Ow = O + (size_t)(b * SEQ + qlo + 4 * hi_e) * DM + h * VDIM + r32_e;
#pragma unroll
    for (int r = 0; r < 16; ++r) { const int orow = (r & 3) + 8 * (r >> 2); const float rl = __builtin_amdgcn_rcpf(li_l[orow + 4 * hi_e]);
#pragma unroll
        for (int d0 = 0; d0 < 4; ++d0) { const float v = o[d0][r] * rl; const float vn = xor_f<1>(v);
            if ((r32_e & 1) == 0) *(GAS unsigned*)(Ow + (size_t)orow * DM + d0 * 32) = cvtpk(v, vn); } }
    __syncthreads();
#undef A_LOAD
#undef A_WRITE
#undef RESC
#undef A_COMPUTE
}
__device__ __forceinline__ void attn_phase(const Ctx& C, const bf16* Q, const bf16* Kb, const bf16* Vb, bf16* O) {
    constexpr int NITEM = NBATCH * MLA_H * 8;
    for (int L = C.vcu; L < NITEM; L += C.G) {
        const int bh = L >> 3, x = L & 7;
        attn_block(C, bh >> 4, bh & 15, 15 - x, Q, Kb, Vb, O);
        attn_block(C, bh >> 4, bh & 15, x, Q, Kb, Vb, O);
    }
}
}

constexpr int NPHASES = 39;
__global__ void __launch_bounds__(NWAVES * 64, 2) fwd_kernel(Args args) {
    extern __shared__ __attribute__((aligned(16))) unsigned char lds_raw[];
    Ctx C0;
    C0.lds = (LAS unsigned char*)lds_raw;
    C0.tid = threadIdx.x; C0.lane = C0.tid & 63; C0.wave = __builtin_amdgcn_readfirstlane(C0.tid >> 6);
    C0.G = gridDim.x; { const int bx = blockIdx.x; C0.vcu = (C0.G % 8 == 0) ? (bx % 8) * (C0.G / 8) + bx / 8 : bx; }
    volatile LAS unsigned* MISC = (volatile LAS unsigned*)(C0.lds + MISC_OFF);
    unsigned char* ws = args.ws;
    gu32* ctl = (gu32*)(ws + WS_CTL);
    for (int u = C0.tid; u < (LDS_BYTES - LDSCTL_OFF) / 4; u += NWAVES * 64) ((LAS unsigned*)(C0.lds + LDSCTL_OFF))[u] = 0u;
    __syncthreads();
#if MK_MULTI
#define GRID_BAR() do { } while (0)
#else
    XcdBarrier bar = xcd_barrier_post((unsigned*)(ctl + CW_BAR), MISC + 8);
#define GRID_BAR() do { XcdBarrier b2_ = bar; asm volatile("" : "+s"(b2_.bar), "+s"(b2_.x)); xcd_barrier(b2_); } while (0)
#endif
    const int lo = args.ph_lo, hi = args.ph_hi;
    int ph = 0;
#define PHASE_BEGIN if (ph >= lo && ph < hi) { const Ctx C = fresh(C0);
#define PHASE_END   if (ph + 1 < hi) GRID_BAR(); } ++ph;

    float* const X = args.out;
    bf16* const Hb = (bf16*)(ws + WS_H);
    unsigned char* const BIG = ws + WS_BIG;
    const float* const mod = (const float*)(ws + WS_MOD);
    const float* const kvmod = (const float*)(ws + WS_KVMOD);
    const f32x2* const rope = (const f32x2*)(ws + WS_ROPE);

    PHASE_BEGIN phase_prologue(args, C); PHASE_END

    for (int layer = 0; layer < DEPTH; ++layer) {
        const float* modl = mod + (size_t)layer * NBATCH * MODW;
        const float* xin = (layer == 0) ? args.x : X;
        PHASE_BEGIN
        if (layer == NA) phase_norm_mod<true>(C, xin, args.norm_mix + layer * DM, modl, modl + DM, MODW, Hb, args.kv_in_norm, kvmod, kvmod + DM, 2 * DM, (bf16*)(BIG + BIG_HKV));
        else phase_norm_mod<false>(C, xin, args.norm_mix + layer * DM, modl, modl + DM, MODW, Hb, nullptr, nullptr, nullptr, 0, nullptr);
        PHASE_END
        if (layer < NA) {
            PHASE_BEGIN { pg8::Gemm g{Hb, (const bf16*)(ws + WS_WIN) + (size_t)layer * 4 * DM * DM, MTOK, 4 * DM, DM}; pg8::StaticOrder S; S.init(MTOK, 4 * DM, C.G, (int)blockIdx.x);
                pg8::EpiBf16<0> E{(bf16*)BIG, 4 * DM}; pg8::gemm_phase<pg8::EpiBf16<0>, pg8::StaticOrder, true, true>(C.lds + RING_OFF, g, S, E); } PHASE_END
            PHASE_BEGIN phase_hgrn_simple(C, args, layer, (const bf16*)BIG, Hb); PHASE_END
            PHASE_BEGIN { pg8::Gemm g{Hb, (const bf16*)(ws + WS_WOUT) + (size_t)layer * DM * DM, MTOK, DM, DM}; pg8::StaticOrder S; S.init(MTOK, DM, C.G, (int)blockIdx.x);
                pg8::EpiResid E{xin, X, DM, modl + 2 * DM, MODW}; pg8::gemm_phase<pg8::EpiResid, pg8::StaticOrder, true, true>(C.lds + RING_OFF, g, S, E); } PHASE_END
        } else {
            const int j = layer - NA;
            if (layer == NA) {
                PHASE_BEGIN { pg8::Gemm g{(const bf16*)(BIG + BIG_HKV), (const bf16*)(ws + WS_WDKV), MTOK, CKVN, DM}; pg8::StaticOrder S; S.init(MTOK, CKVN, C.G, (int)blockIdx.x);
                    pg8::EpiF32 E{(float*)(BIG + BIG_CKV), CKVN}; pg8::gemm_phase<pg8::EpiF32, pg8::StaticOrder, true, true>(C.lds + RING_OFF, g, S, E); } PHASE_END
                PHASE_BEGIN phase_rms512(C, (const float*)(BIG + BIG_CKV), CKVN, args.kv_norm, (bf16*)(BIG + BIG_CLAT)); PHASE_END
                PHASE_BEGIN { pg8::Gemm g{(const bf16*)(BIG + BIG_CLAT), (const bf16*)(ws + WS_WUKV), MTOK, 4096, KVLORA}; pg8::StaticOrder S; S.init(MTOK, 4096, C.G, (int)blockIdx.x);
                    pg8::EpiBf16<0> E{(bf16*)(BIG + BIG_KVRAW), 4096}; pg8::gemm_phase<pg8::EpiBf16<0>, pg8::StaticOrder, true, true>(C.lds + RING_OFF, g, S, E); } PHASE_END
                PHASE_BEGIN phase_kv_build(C, (const bf16*)(BIG + BIG_KVRAW), (const float*)(BIG + BIG_CKV), args.k_norm, rope, (bf16*)(ws + WS_KB), (bf16*)(ws + WS_VB)); PHASE_END
            }
            PHASE_BEGIN { pg8::Gemm g{Hb, (const bf16*)(ws + WS_WDQ) + (size_t)j * DM * QLORA, MTOK, QLORA, DM}; pg8::StaticOrder S; S.init(MTOK, QLORA, C.G, (int)blockIdx.x);
                pg8::EpiF32 E{(float*)(BIG + BIG_CQRAW), QLORA}; pg8::gemm_phase<pg8::EpiF32, pg8::StaticOrder, true, true>(C.lds + RING_OFF, g, S, E); } PHASE_END
            PHASE_BEGIN phase_rms512(C, (const float*)(BIG + BIG_CQRAW), QLORA, args.q_lat_norm + j * QLORA, (bf16*)(BIG + BIG_CQ)); PHASE_END
            PHASE_BEGIN { pg8::Gemm g{(const bf16*)(BIG + BIG_CQ), (const bf16*)(ws + WS_WUQ) + (size_t)j * QLORA * 3072, MTOK, 3072, QLORA}; pg8::StaticOrder S; S.init(MTOK, 3072, C.G, (int)blockIdx.x);
                pg8::EpiBf16<0> E{(bf16*)(BIG + BIG_Q), 3072}; pg8::gemm_phase<pg8::EpiBf16<0>, pg8::StaticOrder, true, true>(C.lds + RING_OFF, g, S, E); } PHASE_END
            PHASE_BEGIN phase_q_post(C, (bf16*)(BIG + BIG_Q), args.q_norm + j * QKD, rope); PHASE_END
            PHASE_BEGIN att::attn_phase(C, (const bf16*)(BIG + BIG_Q), (const bf16*)(ws + WS_KB), (const bf16*)(ws + WS_VB), Hb); PHASE_END
            PHASE_BEGIN { pg8::Gemm g{Hb, (const bf16*)(ws + WS_WO) + (size_t)j * DM * DM, MTOK, DM, DM}; pg8::StaticOrder S; S.init(MTOK, DM, C.G, (int)blockIdx.x);
                pg8::EpiResid E{X, X, DM, modl + 2 * DM, MODW}; pg8::gemm_phase<pg8::EpiResid, pg8::StaticOrder, true, true>(C.lds + RING_OFF, g, S, E); } PHASE_END
        }
        PHASE_BEGIN phase_norm_mod<false>(C, X, args.norm_mlp + layer * DM, modl + 3 * DM, modl + 4 * DM, MODW, Hb, nullptr, nullptr, nullptr, 0, nullptr); PHASE_END
        PHASE_BEGIN { pg8::Gemm g{Hb, (const bf16*)(ws + WS_W1) + (size_t)layer * DM * DFF, MTOK, DFF, DM}; pg8::StaticOrder S; S.init(MTOK, DFF, C.G, (int)blockIdx.x);
            pg8::EpiBf16<1> E{(bf16*)BIG, DFF}; pg8::gemm_phase<pg8::EpiBf16<1>, pg8::StaticOrder, true, true>(C.lds + RING_OFF, g, S, E); } PHASE_END
        PHASE_BEGIN { pg8::Gemm g{(const bf16*)BIG, (const bf16*)(ws + WS_W2) + (size_t)layer * DM * DFF, MTOK, DM, DFF}; pg8::StaticOrder S; S.init(MTOK, DM, C.G, (int)blockIdx.x);
            pg8::EpiResid E{X, X, DM, modl + 5 * DM, MODW}; pg8::gemm_phase<pg8::EpiResid, pg8::StaticOrder, true, true>(C.lds + RING_OFF, g, S, E); } PHASE_END
    }
#undef PHASE_BEGIN
#undef PHASE_END
}

extern "C" void kernel_launch(void* const* d_in, const int* in_sizes, int n_in, void* d_out, int out_size, void* d_ws, size_t ws_size, hipStream_t stream) {
    static int grid = 0;
    if (grid == 0) {
        if (n_in != 25 || in_sizes[0] != MTOK * DM || out_size != MTOK * DM || ws_size < WS_END) {
            fprintf(stderr, "kernel_launch: unexpected shapes / workspace (n_in %d, in0 %d, out %d, ws %zu, need %zu); nothing launched\n", n_in, n_in > 0 ? in_sizes[0] : -1, out_size, ws_size, (size_t)WS_END); grid = -1; return; }
        int dev = 0, cus = 0, per_cu = 0;
        if (hipGetDevice(&dev) != hipSuccess || hipDeviceGetAttribute(&cus, hipDeviceAttributeMultiprocessorCount, dev) != hipSuccess) { grid = -1; return; }
        if (hipFuncSetAttribute((const void*)fwd_kernel, hipFuncAttributeMaxDynamicSharedMemorySize, LDS_BYTES) != hipSuccess) { fprintf(stderr, "kernel_launch: hipFuncSetAttribute failed\n"); grid = -1; return; }
        if (hipOccupancyMaxActiveBlocksPerMultiprocessor(&per_cu, (const void*)fwd_kernel, NWAVES * 64, LDS_BYTES) != hipSuccess || per_cu < 1)
            fprintf(stderr, "kernel_launch: note: occupancy query reports %d workgroups per CU\n", per_cu);
        (void)hipGetLastError();
        grid = cus;
    }
    if (grid < 0) return;
    if (hipMemsetAsync((char*)d_ws + WS_CTL, 0, CTL_ZERO_BYTES, stream) != hipSuccess) return;
    Args a{};
    a.x = (const float*)d_in[0]; a.c = (const float*)d_in[1]; a.positions = (const int*)d_in[2];
    a.ada_w = (const float*)d_in[3]; a.ada_b = (const float*)d_in[4]; a.norm_mix = (const float*)d_in[5]; a.norm_mlp = (const float*)d_in[6];
    a.mlp_w1 = (const float*)d_in[7]; a.mlp_w2 = (const float*)d_in[8]; a.hg_w_in = (const float*)d_in[9]; a.hg_lower = (const float*)d_in[10];
    a.hg_o_norm = (const float*)d_in[11]; a.hg_w_out = (const float*)d_in[12];
    a.kv_ada_w = (const float*)d_in[13]; a.kv_ada_b = (const float*)d_in[14]; a.kv_in_norm = (const float*)d_in[15]; a.w_dkv = (const float*)d_in[16];
    a.kv_norm = (const float*)d_in[17]; a.w_ukv = (const float*)d_in[18]; a.k_norm = (const float*)d_in[19];
    a.w_dq = (const float*)d_in[20]; a.q_lat_norm = (const float*)d_in[21]; a.w_uq = (const float*)d_in[22]; a.q_norm = (const float*)d_in[23]; a.w_o = (const float*)d_in[24];
    a.out = (float*)d_out; a.ws = (unsigned char*)d_ws;
#if MK_MULTI
    for (int p = 0; p < NPHASES; ++p) { a.ph_lo = p; a.ph_hi = p + 1; hipLaunchKernelGGL(fwd_kernel, dim3(grid), dim3(NWAVES * 64), LDS_BYTES, stream, a); }
#else
    a.ph_lo = 0; a.ph_hi = NPHASES;
    hipLaunchKernelGGL(fwd_kernel, dim3(grid), dim3(NWAVES * 64), LDS_BYTES, stream, a);
#endif
    const hipError_t le = hipPeekAtLastError();
    if (le != hipSuccess) fprintf(stderr, "kernel_launch: launch failed: %s\n", hipGetErrorName(le));
}
```

```cpp
#include <hip/hip_runtime.h>
#include <cstdio>
#include <cstdint>

#ifndef MK_MULTI
#define MK_MULTI 0
#endif

namespace pg8 {
#define PG8_LAS __attribute__((address_space(3)))
typedef unsigned short bf16_t;
typedef short bf16x8 __attribute__((ext_vector_type(8)));
typedef float f32x4 __attribute__((ext_vector_type(4)));
typedef unsigned u32x4 __attribute__((ext_vector_type(4)));
constexpr int BM = 256, BK = 64, HALF = 128, HTB = HALF * BK * 2, STAGE_BYTES = 8 * HTB, NXCD = 8, WGM = 8;

__host__ __device__ __forceinline__ int lds_byte(int r, int c) { const int st = (r >> 4) * 2 + (c >> 5), rr = r & 15, cc = c & 31, ob = rr * 64 + cc * 2; return st * 1024 + (ob ^ (((ob >> 9) & 1) << 5)); }
__host__ __device__ __forceinline__ void stage_rc(int b, int& R, int& C) { const int st = b / 1024, sb = b % 1024, swz = sb ^ (((sb >> 9) & 1) << 5); R = (st >> 1) * 16 + swz / 64; C = (st & 1) * 32 + (swz % 64) / 2; }
__host__ __device__ __forceinline__ int perm32(int rho) { const int n = rho >> 4, i = rho & 15; return 8 * (i >> 2) + 4 * n + (i & 3); }

struct Unit { int pm, pn; };
struct Gemm { const bf16_t* A; const bf16_t* Bt; int M, N, K; };

struct StaticOrder {
    int nM, nN, nwg, G, c;
    __host__ __device__ void init(int M, int N, int G_, int c_) { nM = M / BM; nN = N / BM; nwg = nM * nN; G = G_; c = c_; }
    __host__ __device__ bool next(int i, Unit& u) const {
        const long L = (long)i * G + c; if (L >= nwg) return false;
        int wgid = (int)L; { const int q = nwg / NXCD, r = nwg % NXCD, xcd = wgid % NXCD, off = wgid / NXCD; wgid = (xcd < r ? xcd * (q + 1) : r * (q + 1) + (xcd - r) * q) + off; }
        const int nig = WGM * nN, gid = wgid / nig, fm = gid * WGM, gsz = (nM - fm) < WGM ? (nM - fm) : WGM;
        u.pm = fm + ((wgid % nig) % gsz); u.pn = (wgid % nig) / gsz; return true;
    }
    __device__ __forceinline__ void a_ready(const Unit&) const {}
    __device__ __forceinline__ void done(const Unit&) const {}
};

__device__ __forceinline__ unsigned cvt_pk_bf16(float lo, float hi) { unsigned r; asm volatile("v_cvt_pk_bf16_f32 %0, %1, %2" : "=v"(r) : "v"(lo), "v"(hi)); return r; }

template <int ACT  > struct EpiBf16 {
    static constexpr bool PERM = true, AFTER_DRAIN = false;
    bf16_t* O; int ldc;
    __device__ __forceinline__ void operator()(const f32x4 (&acc)[2][2][4][2], const Unit& u, int wr, int wc, int fr, int fq) const {
        const int row0 = u.pm * BM + wr * 64 + fr; const int col0 = u.pn * BM + wc * 32 + 8 * fq;
#pragma unroll
        for (int ai = 0; ai < 2; ++ai)
#pragma unroll
            for (int m = 0; m < 4; ++m) { bf16_t* rowp = O + (size_t)(row0 + ai * HALF + m * 16) * ldc + col0;
#pragma unroll
                for (int bj = 0; bj < 2; ++bj) { f32x4 v0 = acc[ai][bj][m][0], v1 = acc[ai][bj][m][1];
                    if (ACT == 1) {
#pragma unroll
                        for (int j = 0; j < 4; ++j) { const float a = fmaxf(v0[j], 0.f), b = fmaxf(v1[j], 0.f); v0[j] = a * a; v1[j] = b * b; } }
                    u32x4 w; w.x = cvt_pk_bf16(v0[0], v0[1]); w.y = cvt_pk_bf16(v0[2], v0[3]); w.z = cvt_pk_bf16(v1[0], v1[1]); w.w = cvt_pk_bf16(v1[2], v1[3]);
                    *(u32x4*)(rowp + bj * HALF) = w; } }
    }
};
struct EpiF32 {
    static constexpr bool PERM = false, AFTER_DRAIN = false;
    float* C; int ldc;
    __device__ __forceinline__ void operator()(const f32x4 (&acc)[2][2][4][2], const Unit& u, int wr, int wc, int fr, int fq) const {
        const int row0 = u.pm * BM + wr * 64 + fr, col0 = u.pn * BM + wc * 32 + 4 * fq;
#pragma unroll
        for (int ai = 0; ai < 2; ++ai)
#pragma unroll
            for (int m = 0; m < 4; ++m) { float* rowp = C + (size_t)(row0 + ai * HALF + m * 16) * ldc + col0;
#pragma unroll
                for (int bj = 0; bj < 2; ++bj)
#pragma unroll
                    for (int n = 0; n < 2; ++n) *(f32x4*)(rowp + bj * HALF + n * 16) = acc[ai][bj][m][n]; }
    }
};
struct EpiResid {
    static constexpr bool PERM = false, AFTER_DRAIN = false;
    const float* base; float* out; int ldc; const float* gate; int gstride;
    __device__ __forceinline__ void operator()(const f32x4 (&acc)[2][2][4][2], const Unit& u, int wr, int wc, int fr, int fq) const {
        const int row0 = u.pm * BM + wr * 64 + fr, col0 = u.pn * BM + wc * 32 + 4 * fq;
        const float* gp = gate + (size_t)(u.pm >> 4) * gstride + col0;
        f32x4 gv[2][2];
#pragma unroll
        for (int bj = 0; bj < 2; ++bj)
#pragma unroll
            for (int n = 0; n < 2; ++n) gv[bj][n] = *(const f32x4*)(gp + bj * HALF + n * 16);
#pragma unroll
        for (int ai = 0; ai < 2; ++ai)
#pragma unroll
            for (int m = 0; m < 4; ++m) { const size_t off = (size_t)(row0 + ai * HALF + m * 16) * ldc + col0;
#pragma unroll
                for (int bj = 0; bj < 2; ++bj)
#pragma unroll
                    for (int n = 0; n < 2; ++n) { const f32x4 bs = *(const f32x4*)(base + off + bj * HALF + n * 16);
                        *(f32x4*)(out + off + bj * HALF + n * 16) = bs + gv[bj][n] * acc[ai][bj][m][n]; }
                asm volatile("" ::: "memory"); }
    }
};

template <class Epi, class Sched, bool ALIGN_EPI = false, bool SP2 = false>
__device__ __forceinline__ void gemm_phase(PG8_LAS unsigned char* lds, const Gemm g, const Sched& S, const Epi& E) {
    int tid_ = threadIdx.x; asm volatile("" : "+v"(tid_));
    const int tid = tid_, wid = __builtin_amdgcn_readfirstlane(tid >> 6), lane = tid & 63, wr = wid >> 2, wc = wid & 3, fr = lane & 15, fq = lane >> 4;
    const int K = g.K, nt = K / BK;
    unsigned voffA[2], voffB[2];
#pragma unroll
    for (int i = 0; i < 2; ++i) { int R, C; stage_rc(tid * 16 + i * 8192, R, C); const int Rb = Epi::PERM ? ((R & ~31) + perm32(R & 31)) : R;
        voffA[i] = (unsigned)(R * K + C) * 2u; voffB[i] = (unsigned)(Rb * K + C) * 2u; }
    const size_t kstep = (size_t)(BK * 2);
    const size_t hstep = (size_t)HALF * K * 2;
    const size_t tstep = 2 * hstep;
    const unsigned ldsw = (unsigned)wid * 1024u;
    const int aoff = lds_byte(wr * 64 + fr, fq * 8), boff = lds_byte(wc * 32 + fr, fq * 8);
#define PG8_SA(b, h) (((b) * 2 + (h)) * HTB)
#define PG8_SB(b, h) ((4 + (b) * 2 + (h)) * HTB)
#define PG8_STAGE(bufoff, gbase, voff) do { _Pragma("unroll") for (int _i = 0; _i < 2; ++_i) \
        __builtin_amdgcn_global_load_lds((const unsigned*)((const char*)(gbase) + (voff)[_i]), (PG8_LAS unsigned*)(lds + (bufoff) + ldsw + _i * 8192), 16, 0, 0); } while (0)
#define PG8_LDA(dst, b, h) do { _Pragma("unroll") for (int m = 0; m < 4; ++m) _Pragma("unroll") for (int k = 0; k < 2; ++k) dst[m][k] = *(const PG8_LAS bf16x8*)(lds + PG8_SA(b, h) + aoff + m * 2048 + k * 1024); } while (0)
#define PG8_LDB(dst, b, h) do { _Pragma("unroll") for (int n = 0; n < 2; ++n) _Pragma("unroll") for (int k = 0; k < 2; ++k) dst[n][k] = *(const PG8_LAS bf16x8*)(lds + PG8_SB(b, h) + boff + n * 2048 + k * 1024); } while (0)
#define PG8_MMA(ai, bj, At, Bt) do { __builtin_amdgcn_s_setprio(1); _Pragma("unroll") for (int m = 0; m < 4; ++m) _Pragma("unroll") for (int n = 0; n < 2; ++n) _Pragma("unroll") for (int k = 0; k < 2; ++k) \
        acc[ai][bj][m][n] = __builtin_amdgcn_mfma_f32_16x16x32_bf16(Bt[n][k], At[m][k], acc[ai][bj][m][n], 0, 0, 0); __builtin_amdgcn_s_setprio(0); } while (0)
#define PG8_WAIT_V(n) asm volatile("s_waitcnt vmcnt(" #n ")" ::: "memory")
#define PG8_WAIT_L(n) asm volatile("s_waitcnt lgkmcnt(" #n ")" ::: "memory")
#define PG8_BAR __builtin_amdgcn_s_barrier()
#define PG8_SCHED __builtin_amdgcn_sched_barrier(0)
    Unit cur, nxt; int ui = 0;
    if (!S.next(0, cur)) return;
    f32x4 acc[2][2][4][2];
#pragma unroll
    for (int a = 0; a < 2; ++a)
#pragma unroll
        for (int b = 0; b < 2; ++b)
#pragma unroll
            for (int m = 0; m < 4; ++m)
#pragma unroll
                for (int n = 0; n < 2; ++n) acc[a][b][m][n] = (f32x4){0.f, 0.f, 0.f, 0.f};
    bf16x8 At[4][2], B0[2][2], B1[2][2];
    const char* cA = (const char*)g.A + (size_t)cur.pm * tstep; const char* cB = (const char*)g.Bt + (size_t)cur.pn * tstep;
    S.a_ready(cur);
    if constexpr (SP2) {
        PG8_STAGE(PG8_SB(0, 0), cB, voffB); PG8_STAGE(PG8_SB(0, 1), cB + hstep, voffB); PG8_STAGE(PG8_SA(0, 0), cA, voffA); PG8_STAGE(PG8_SA(0, 1), cA + hstep, voffA);
        if (wr == 1) PG8_BAR;
        PG8_WAIT_V(2); PG8_BAR;
        PG8_STAGE(PG8_SB(1, 0), cB + kstep, voffB); PG8_STAGE(PG8_SA(1, 0), cA + kstep, voffA); PG8_STAGE(PG8_SB(1, 1), cB + hstep + kstep, voffB);
        PG8_WAIT_V(6); PG8_BAR;
    } else {
        PG8_STAGE(PG8_SB(0, 0), cB, voffB); PG8_STAGE(PG8_SA(0, 0), cA, voffA); PG8_STAGE(PG8_SB(0, 1), cB + hstep, voffB); PG8_STAGE(PG8_SA(0, 1), cA + hstep, voffA);
        if (wr == 1) PG8_BAR;
        PG8_WAIT_V(4); PG8_BAR;
        PG8_STAGE(PG8_SB(1, 0), cB + kstep, voffB); PG8_STAGE(PG8_SA(1, 0), cA + kstep, voffA); PG8_STAGE(PG8_SB(1, 1), cB + hstep + kstep, voffB);
        PG8_WAIT_V(6); PG8_BAR;
    }
    for (;;) {
        const bool has_next = S.next(ui + 1, nxt);
        const char* nA = has_next ? (const char*)g.A + (size_t)nxt.pm * tstep : cA; const char* nB = has_next ? (const char*)g.Bt + (size_t)nxt.pn * tstep : cB;
        for (int t = 0; t < nt; t += 2) {
            const bool last = (t == nt - 2);
            const char* a1 = cA + (size_t)(t + 1) * kstep;
            const char* a2 = last ? nA : cA + (size_t)(t + 2) * kstep; const char* b2 = last ? nB : cB + (size_t)(t + 2) * kstep;
            const char* a3 = a2 + kstep; const char* b3 = b2 + kstep;
            if (last && has_next) S.a_ready(nxt);
            if constexpr (SP2) {
            PG8_LDB(B0, 0, 0); PG8_LDB(B1, 0, 1); PG8_SCHED; PG8_LDA(At, 0, 0); PG8_STAGE(PG8_SA(1, 1), a1 + hstep, voffA);
            PG8_WAIT_V(8); PG8_WAIT_L(0); PG8_BAR; PG8_MMA(0, 0, At, B0); PG8_MMA(0, 1, At, B1); PG8_BAR; PG8_SCHED;
            PG8_LDA(At, 0, 1); PG8_STAGE(PG8_SB(0, 0), b2, voffB); PG8_STAGE(PG8_SB(0, 1), b2 + hstep, voffB); PG8_STAGE(PG8_SA(0, 0), a2, voffA);
            PG8_WAIT_V(8); PG8_WAIT_L(0); PG8_BAR; PG8_MMA(1, 0, At, B0); PG8_MMA(1, 1, At, B1); PG8_BAR; PG8_SCHED;
            PG8_LDB(B0, 1, 0); PG8_LDB(B1, 1, 1); PG8_SCHED; PG8_LDA(At, 1, 0); PG8_STAGE(PG8_SA(0, 1), a2 + hstep, voffA);
            PG8_WAIT_V(8); PG8_WAIT_L(0); PG8_BAR; PG8_MMA(0, 0, At, B0); PG8_MMA(0, 1, At, B1); PG8_BAR; PG8_SCHED;
            PG8_LDA(At, 1, 1); PG8_STAGE(PG8_SB(1, 0), b3, voffB); PG8_STAGE(PG8_SB(1, 1), b3 + hstep, voffB); PG8_STAGE(PG8_SA(1, 0), a3, voffA);
            PG8_WAIT_V(8); PG8_WAIT_L(0); PG8_BAR; PG8_MMA(1, 0, At, B0); PG8_MMA(1, 1, At, B1); PG8_BAR; PG8_SCHED;
            } else {
            PG8_LDB(B0, 0, 0); PG8_SCHED; PG8_LDA(At, 0, 0); PG8_STAGE(PG8_SA(1, 1), a1 + hstep, voffA);
            PG8_WAIT_L(8); PG8_BAR; PG8_WAIT_L(0); PG8_MMA(0, 0, At, B0); PG8_BAR; PG8_SCHED;
            PG8_LDB(B1, 0, 1); PG8_STAGE(PG8_SB(0, 0), b2, voffB);
            PG8_BAR; PG8_WAIT_L(0); PG8_MMA(0, 1, At, B1); PG8_BAR;
            PG8_LDA(At, 0, 1); PG8_STAGE(PG8_SA(0, 0), a2, voffA);
            PG8_BAR; PG8_WAIT_L(0); PG8_MMA(1, 0, At, B0); PG8_BAR; PG8_SCHED;
            PG8_STAGE(PG8_SB(0, 1), b2 + hstep, voffB);
            PG8_WAIT_V(6); PG8_BAR; PG8_MMA(1, 1, At, B1); PG8_BAR;
            PG8_LDB(B0, 1, 0); PG8_SCHED; PG8_LDA(At, 1, 0); PG8_STAGE(PG8_SA(0, 1), a2 + hstep, voffA);
            PG8_WAIT_L(8); PG8_BAR; PG8_WAIT_L(0); PG8_MMA(0, 0, At, B0); PG8_BAR; PG8_SCHED;
            PG8_LDB(B1, 1, 1); PG8_STAGE(PG8_SB(1, 0), b3, voffB);
            PG8_BAR; PG8_WAIT_L(0); PG8_MMA(0, 1, At, B1); PG8_BAR;
            PG8_LDA(At, 1, 1); PG8_STAGE(PG8_SA(1, 0), a3, voffA);
            PG8_BAR; PG8_WAIT_L(0); PG8_MMA(1, 0, At, B0); PG8_BAR; PG8_SCHED;
            PG8_STAGE(PG8_SB(1, 1), b3 + hstep, voffB);
            PG8_WAIT_V(6); PG8_BAR; PG8_MMA(1, 1, At, B1); PG8_BAR;
            }
        }
        if constexpr (ALIGN_EPI) { if (wr == 0) PG8_BAR; }
        E(acc, cur, wr, wc, fr, fq); S.done(cur);
        if (!has_next) break;
#pragma unroll
        for (int a = 0; a < 2; ++a)
#pragma unroll
            for (int b = 0; b < 2; ++b)
#pragma unroll
                for (int m = 0; m < 4; ++m)
#pragma unroll
                    for (int n = 0; n < 2; ++n) acc[a][b][m][n] = (f32x4){0.f, 0.f, 0.f, 0.f};
        cur = nxt; cA = nA; cB = nB; ++ui;
        if constexpr (ALIGN_EPI) { if (wr == 1) PG8_BAR; }
    }
    PG8_WAIT_V(0);
    if constexpr (!ALIGN_EPI) { if (wr == 0) PG8_BAR; }
    PG8_BAR;
#undef PG8_SA
#undef PG8_SB
#undef PG8_STAGE
#undef PG8_LDA
#undef PG8_LDB
#undef PG8_MMA
#undef PG8_WAIT_V
#undef PG8_WAIT_L
#undef PG8_BAR
#undef PG8_SCHED
}
}

constexpr int NWAVES = 8;
constexpr int DM = 2048, NBATCH = 8, SEQ = 4096, MTOK = NBATCH * SEQ, DEPTH = 4, NA = 2;
constexpr int HG_H = 16, HG_D = 128;
constexpr int MLA_H = 16, NOPE = 128, ROPE = 64, VDIM = 128, QKD = 192, QLORA = 512, KVLORA = 512, CKVN = 768  ;
constexpr int DFF = 8192, NMOD = 6, MODW = NMOD * DM;
constexpr float EPS = 1e-6f;

constexpr size_t MiB = 1u << 20;
constexpr size_t WS_CTL = 0, CTL_ZERO_BYTES = 1 * MiB;
constexpr size_t WS_MOD = 1 * MiB;
constexpr size_t WS_KVMOD = WS_MOD + 1536 * 1024;
constexpr size_t WS_ROPE = 3 * MiB;
constexpr size_t WS_WIN = 16 * MiB;
constexpr size_t WS_WOUT = 80 * MiB;
constexpr size_t WS_W1 = 96 * MiB;
constexpr size_t WS_W2 = 224 * MiB;
constexpr size_t WS_WDKV = 352 * MiB;
constexpr size_t WS_WUKV = 355 * MiB;
constexpr size_t WS_WDQ = 359 * MiB;
constexpr size_t WS_WUQ = 363 * MiB;
constexpr size_t WS_WO = 369 * MiB;
constexpr size_t WS_H = 385 * MiB;
constexpr size_t WS_BIG = 513 * MiB;
constexpr size_t WS_KB = 1025 * MiB;
constexpr size_t WS_VB = 1217 * MiB;
constexpr size_t WS_END = 1345 * MiB;
constexpr size_t BIG_HKV = 0, BIG_KVRAW = 128 * MiB, BIG_CKV = 384 * MiB, BIG_CLAT = 480 * MiB;
constexpr size_t BIG_Q = 0, BIG_CQRAW = 192 * MiB, BIG_CQ = 256 * MiB;

constexpr int CW_TMO = 0, CW_CODE = 1, CW_BAR = 4096;

constexpr int RING_OFF = 0, RING_BYTES = 131072;
constexpr int LDSCTL_OFF = RING_BYTES, MISC_OFF = LDSCTL_OFF + 320;
constexpr int LDS_BYTES = 147456;

#define GAS __attribute__((address_space(1)))
#define LAS __attribute__((address_space(3)))
typedef unsigned short bf16;
typedef unsigned v4u __attribute__((ext_vector_type(4)));
typedef unsigned v2u __attribute__((ext_vector_type(2)));
typedef float f32x4 __attribute__((ext_vector_type(4)));
typedef float f32x2 __attribute__((ext_vector_type(2)));
typedef float f32x16 __attribute__((ext_vector_type(16)));
typedef short bf16x8 __attribute__((ext_vector_type(8)));
typedef short s16x4 __attribute__((ext_vector_type(4)));
typedef GAS unsigned gu32;
#define RLX_AGENT __ATOMIC_RELAXED, __HIP_MEMORY_SCOPE_AGENT
#define LDS_WAIT() asm volatile("s_waitcnt lgkmcnt(0)" ::: "memory")
#define VM_WAIT() asm volatile("s_waitcnt vmcnt(0)" ::: "memory")
__device__ __forceinline__ unsigned f2bf(float f) { unsigned u = __builtin_bit_cast(unsigned, f); return (u + 0x7fffu + ((u >> 16) & 1u)) >> 16; }
__device__ __forceinline__ unsigned pk2(float lo, float hi) { return f2bf(lo) | (f2bf(hi) << 16); }
__device__ __forceinline__ float bflo(unsigned w) { return __builtin_bit_cast(float, w << 16); }
__device__ __forceinline__ float bfhi(unsigned w) { return __builtin_bit_cast(float, w & 0xffff0000u); }

#define XB_TMO      128
#define XB_XCNT(j)  (256  + 64 * (j))
#define XB_XSUB(j)  (1280 + 64 * (j))
#define XB_XGEN(j)  (2304 + 64 * (j))
#define XB_TOP      3328
#define XB_TOPGEN   3392
#define XCD_BAR_WORDS 3456
#define XB_SPIN_CAP (1u << 22)

__device__ __forceinline__ unsigned xb_ld(unsigned* p)              { return __hip_atomic_load(p, __ATOMIC_RELAXED, __HIP_MEMORY_SCOPE_AGENT); }
__device__ __forceinline__ unsigned xb_add(unsigned* p, unsigned v) { return __hip_atomic_fetch_add(p, v, __ATOMIC_RELAXED, __HIP_MEMORY_SCOPE_AGENT); }
__device__ __forceinline__ unsigned xb_xcc_id() { return (unsigned)__builtin_amdgcn_s_getreg((3 << 11) | 20) & 0xFu; }
#define XB_SPIN(cond, bar) do { unsigned _sp = 0; while (cond) { __builtin_amdgcn_s_sleep(1); \
    if ((++_sp & 255u) == 0u) { if (xb_ld(&(bar)[XB_TMO])) break; if (_sp > XB_SPIN_CAP) { atomicAdd(&(bar)[XB_TMO], 1u); break; } } } } while (0)

struct XcdBarrier { unsigned* bar; unsigned x; volatile LAS unsigned* st; };

__device__ __forceinline__ XcdBarrier xcd_barrier_post(unsigned* bar, volatile LAS unsigned* st) {
    XcdBarrier b; b.bar = bar; b.x = xb_xcc_id(); b.st = st;
    if (threadIdx.x == 0) (void)xb_add(&bar[XB_XCNT(b.x)], 1u);
    return b;
}
__device__ __forceinline__ void xcd_barrier_complete(unsigned* bar, unsigned x, unsigned& nloc, unsigned& nx) {
    const unsigned G = gridDim.x * gridDim.y * gridDim.z;
    unsigned sum, cnt, mine, sp = 0u;
    for (;;) {
        sum = 0u; cnt = 0u; mine = 0u;
#pragma unroll
        for (unsigned j = 0; j < 16; ++j) { const unsigned c = xb_ld(&bar[XB_XCNT(j)]); sum += c; cnt += (c > 0u) ? 1u : 0u; mine = (j == x) ? c : mine; }
        if (sum == G) break;
        __builtin_amdgcn_s_sleep(1);
        if ((++sp & 255u) == 0u) { if (xb_ld(&bar[XB_TMO])) break; if (sp > XB_SPIN_CAP) { atomicAdd(&bar[XB_TMO], 1u); break; } }
    }
    nloc = mine > 0u ? mine : 1u; nx = cnt > 0u ? cnt : 1u;
}
__device__ __forceinline__ void xcd_barrier(const XcdBarrier& b) {
    asm volatile("s_waitcnt vmcnt(0)" ::: "memory");
    __syncthreads();
    if (threadIdx.x == 0) {
        unsigned* bar = b.bar;
        __builtin_amdgcn_s_waitcnt(0);
        unsigned nloc = b.st[0], nx = b.st[1];
        if (nloc == 0u) { xcd_barrier_complete(bar, b.x, nloc, nx); b.st[0] = nloc; b.st[1] = nx; }
        const unsigned old = xb_add(&bar[XB_XSUB(b.x)], 1u);
        const unsigned gen = old / nloc;
        if (old + 1u == (gen + 1u) * nloc) {
            __builtin_amdgcn_fence(__ATOMIC_RELEASE, "agent");
            asm volatile("s_waitcnt vmcnt(0)" ::: "memory");
            const unsigned og = xb_add(&bar[XB_TOP], 1u);
            const unsigned tg = og / nx;
            if (og + 1u == (tg + 1u) * nx) xb_add(&bar[XB_TOPGEN], 1u);
            else XB_SPIN(xb_ld(&bar[XB_TOPGEN]) == tg, bar);
            __builtin_amdgcn_fence(__ATOMIC_ACQUIRE, "agent");
            xb_add(&bar[XB_XGEN(b.x)], 1u);
            asm volatile("s_waitcnt vmcnt(0)" ::: "memory");
        } else {
            XB_SPIN(xb_ld(&bar[XB_XGEN(b.x)]) == gen, bar);
            __builtin_amdgcn_fence(__ATOMIC_ACQUIRE, "agent");
            asm volatile("s_waitcnt vmcnt(0)" ::: "memory");
        }
    }
    __syncthreads();
}

struct Args {
    const float* x; const float* c; const int* positions;
    const float* ada_w; const float* ada_b; const float* norm_mix; const float* norm_mlp;
    const float* mlp_w1; const float* mlp_w2; const float* hg_w_in; const float* hg_lower; const float* hg_o_norm; const float* hg_w_out;
    const float* kv_ada_w; const float* kv_ada_b; const float* kv_in_norm; const float* w_dkv; const float* kv_norm; const float* w_ukv; const float* k_norm;
    const float* w_dq; const float* q_lat_norm; const float* w_uq; const float* q_norm; const float* w_o;
    float* out; unsigned char* ws;
    int ph_lo, ph_hi;
};

struct Ctx { LAS unsigned char* lds; int tid, lane, wave, vcu, G; };
__device__ __forceinline__ Ctx fresh(const Ctx& C0) { Ctx C = C0; int t = threadIdx.x; asm volatile("" : "+v"(t)); C.tid = t; C.lane = t & 63; C.wave = __builtin_amdgcn_readfirstlane(t >> 6); return C; }

template <int MASK> __device__ __forceinline__ float xor_f(float v) {
    static_assert(MASK >= 1 && MASK <= 16, "xor_f: in-half masks only; use xor32 for the half exchange");
    return __int_as_float(__builtin_amdgcn_ds_swizzle(__float_as_int(v), (MASK << 10) | 0x1f));
}
__device__ __forceinline__ float xor32(float v, int lane) {
    auto rr = __builtin_amdgcn_permlane32_swap(__float_as_uint(v), __float_as_uint(v), false, false); return lane < 32 ? __uint_as_float(rr[1]) : __uint_as_float(rr[0]);
}
__device__ __forceinline__ float wave_sum(float v) {
    v += xor_f<1>(v); v += xor_f<2>(v); v += xor_f<4>(v); v += xor_f<8>(v); v += xor_f<16>(v);
    { auto rr = __builtin_amdgcn_permlane32_swap(__float_as_uint(v), __float_as_uint(v), false, false); v = __uint_as_float(rr[0]) + __uint_as_float(rr[1]); }
    return v;
}

__device__ __forceinline__ void p0_transpose_item(const float* W, int K, int N, bf16* WT, LAS float* scr, int item, int lane) {
    const int nblk = N / 32, kb = item / nblk, nb = item % nblk, k0 = 64 * kb, n0 = 32 * nb;
#pragma unroll 8
    for (int i = 0; i < 32; ++i) { const int kk = 2 * i + (lane >> 5); scr[kk * 33 + (lane & 31)] = W[(size_t)(k0 + kk) * N + n0 + (lane & 31)]; }
    LDS_WAIT(); asm volatile("" ::: "memory");
    const int c = lane & 7;
#pragma unroll
    for (int j = 0; j < 4; ++j) { const int n = (lane >> 3) + 8 * j; const LAS float* s = scr + (8 * c) * 33 + n;
        v4u o; o.x = pk2(s[0 * 33], s[1 * 33]); o.y = pk2(s[2 * 33], s[3 * 33]); o.z = pk2(s[4 * 33], s[5 * 33]); o.w = pk2(s[6 * 33], s[7 * 33]);
        *(GAS v4u*)(WT + (size_t)(n0 + n) * K + k0 + 8 * c) = o; }
    LDS_WAIT(); asm volatile("" ::: "memory");
}

__device__ __forceinline__ void phase_prologue(const Args& a, const Ctx& C) {
    unsigned char* ws = a.ws;
    {
        LAS float* scr = (LAS float*)(C.lds + RING_OFF + C.wave * 16384);
        const int gw = C.vcu * NWAVES + C.wave, NGW = C.G * NWAVES;
        constexpr int I_IN = (DM / 64) * (4 * DM / 32), I_SQ = (DM / 64) * (DM / 32), I_W1 = (DM / 64) * (DFF / 32), I_W2 = (DFF / 64) * (DM / 32);
        constexpr int I_DKV = (DM / 64) * (576 / 32), I_UKV = (KVLORA / 64) * (4096 / 32), I_DQ = (DM / 64) * (QLORA / 32), I_UQ = (QLORA / 64) * (3072 / 32);
        constexpr int NITEMS = 2 * I_IN + 2 * I_SQ + 4 * I_W1 + 4 * I_W2 + I_DKV + I_UKV + 2 * I_DQ + 2 * I_UQ + 2 * I_SQ;
        for (int it = gw; it < NITEMS; it += NGW) {
            int r = it;
            if (r < 2 * I_IN) { const int l = r / I_IN; p0_transpose_item(a.hg_w_in + (size_t)l * DM * 4 * DM, DM, 4 * DM, (bf16*)(ws + WS_WIN) + (size_t)l * 4 * DM * DM, scr, r % I_IN, C.lane); continue; } r -= 2 * I_IN;
            if (r < 2 * I_SQ) { const int l = r / I_SQ; p0_transpose_item(a.hg_w_out + (size_t)l * DM * DM, DM, DM, (bf16*)(ws + WS_WOUT) + (size_t)l * DM * DM, scr, r % I_SQ, C.lane); continue; } r -= 2 * I_SQ;
            if (r < 4 * I_W1) { const int l = r / I_W1; p0_transpose_item(a.mlp_w1 + (size_t)l * DM * DFF, DM, DFF, (bf16*)(ws + WS_W1) + (size_t)l * DM * DFF, scr, r % I_W1, C.lane); continue; } r -= 4 * I_W1;
            if (r < 4 * I_W2) { const int l = r / I_W2; p0_transpose_item(a.mlp_w2 + (size_t)l * DM * DFF, DFF, DM, (bf16*)(ws + WS_W2) + (size_t)l * DM * DFF, scr, r % I_W2, C.lane); continue; } r -= 4 * I_W2;
            if (r < I_DKV) { p0_transpose_item(a.w_dkv, DM, 576, (bf16*)(ws + WS_WDKV), scr, r, C.lane); continue; } r -= I_DKV;
            if (r < I_UKV) { p0_transpose_item(a.w_ukv, KVLORA, 4096, (bf16*)(ws + WS_WUKV), scr, r, C.lane); continue; } r -= I_UKV;
            if (r < 2 * I_DQ) { const int l = r / I_DQ; p0_transpose_item(a.w_dq + (size_t)l * DM * QLORA, DM, QLORA, (bf16*)(ws + WS_WDQ) + (size_t)l * DM * QLORA, scr, r % I_DQ, C.lane); continue; } r -= 2 * I_DQ;
            if (r < 2 * I_UQ) { const int l = r / I_UQ; p0_transpose_item(a.w_uq + (size_t)l * QLORA * 3072, QLORA, 3072, (bf16*)(ws + WS_WUQ) + (size_t)l * QLORA * 3072, scr, r % I_UQ, C.lane); continue; } r -= 2 * I_UQ;
            { const int l = r / I_SQ; p0_transpose_item(a.w_o + (size_t)l * DM * DM, DM, DM, (bf16*)(ws + WS_WO) + (size_t)l * DM * DM, scr, r % I_SQ, C.lane); }
        }
        { v4u z = {0u, 0u, 0u, 0u}; GAS v4u* p = (GAS v4u*)((bf16*)(ws + WS_WDKV) + (size_t)576 * DM); const int n16 = (768 - 576) * DM * 2 / 16;
          for (int i = C.vcu * 512 + C.tid; i < n16; i += C.G * 512) p[i] = z; }
    }
    {
        GAS f32x2* tab = (GAS f32x2*)(ws + WS_ROPE);
        for (int idx = C.vcu * 512 + C.tid; idx < MTOK * 32; idx += C.G * 512) {
            const int m = idx >> 5, i = idx & 31;
            const float inv = exp2f(-(float)i * 0.41524101186092029f);
            const float ang = (float)a.positions[m] * inv;
            const float n = rintf(ang * 0.15915494309189535f);
            float r = fmaf(-n, 6.2831854820251465f, ang); r = fmaf(-n, -1.7484555e-7f, r);
            tab[idx] = (f32x2){__cosf(r), __sinf(r)};
        }
    }
    __syncthreads();
    {
        LAS float* cs = (LAS float*)(C.lds + RING_OFF);
        LAS float* red = (LAS float*)(C.lds + RING_OFF + 65536);
        for (int i = C.tid; i < NBATCH * DM; i += 512) { const int b = i >> 11, k = i & 2047; const float v = a.c[i]; cs[k * 8 + b] = v / (1.0f + __expf(-v)); }
        __syncthreads();
        constexpr int U_ADA = DEPTH * MODW / 256, U_KV = 2 * DM / 256;
        for (int u = C.vcu; u < U_ADA + U_KV; u += C.G) {
            const float* W; const float* bias; float* outp; int N, n0;
            if (u < U_ADA) { const int l = u / (MODW / 256); n0 = (u % (MODW / 256)) * 256; N = MODW; W = a.ada_w + (size_t)l * DM * MODW; bias = a.ada_b + (size_t)l * MODW; outp = (float*)(ws + WS_MOD) + (size_t)l * NBATCH * MODW; }
            else { n0 = (u - U_ADA) * 256; N = 2 * DM; W = a.kv_ada_w; bias = a.kv_ada_b; outp = (float*)(ws + WS_KVMOD); }
            f32x4 acc[8];
#pragma unroll
            for (int b = 0; b < 8; ++b) acc[b] = (f32x4){0.f, 0.f, 0.f, 0.f};
            const float* wp = W + (size_t)(C.wave * 256) * N + n0 + 4 * C.lane;
#pragma unroll 4
            for (int k = 0; k < 256; ++k) {
                const f32x4 w4 = *(const f32x4*)(wp + (size_t)k * N);
                const f32x4 c0 = *(const LAS f32x4*)(cs + (C.wave * 256 + k) * 8), c1 = *(const LAS f32x4*)(cs + (C.wave * 256 + k) * 8 + 4);
                acc[0] += w4 * c0[0]; acc[1] += w4 * c0[1]; acc[2] += w4 * c0[2]; acc[3] += w4 * c0[3];
                acc[4] += w4 * c1[0]; acc[5] += w4 * c1[1]; acc[6] += w4 * c1[2]; acc[7] += w4 * c1[3];
            }
#pragma unroll
            for (int b = 0; b < 8; ++b) *(LAS f32x4*)(red + (C.wave * 8 + b) * 256 + 4 * C.lane) = acc[b];
            __syncthreads();
            { const int b = C.tid >> 6, cl = 4 * (C.tid & 63); f32x4 s = *(const f32x4*)(bias + n0 + cl);
#pragma unroll
              for (int w = 0; w < 8; ++w) s += *(const LAS f32x4*)(red + (w * 8 + b) * 256 + cl);
              *(f32x4*)(outp + (size_t)b * N + n0 + cl) = s; }
            __syncthreads();
        }
    }
}

template <bool DUAL>
__device__ __forceinline__ void phase_norm_mod(const Ctx& C, const float* xin, const float* g1, const float* sh1, const float* sc1, int mstride1, bf16* o1,
                                               const float* g2, const float* sh2, const float* sc2, int mstride2, bf16* o2) {
    const int gw = C.vcu * NWAVES + C.wave, NGW = C.G * NWAVES;
    for (int m = gw; m < MTOK; m += NGW) {
        const int b = m >> 12;
        const f32x4* xr = (const f32x4*)(xin + (size_t)m * DM) + C.lane;
        f32x4 v[8]; float s = 0.f;
#pragma unroll
        for (int j = 0; j < 8; ++j) { v[j] = xr[64 * j]; s += (v[j].x * v[j].x + v[j].y * v[j].y) + (v[j].z * v[j].z + v[j].w * v[j].w); }
        const float rstd = 1.0f / sqrtf(wave_sum(s) * (1.0f / DM) + EPS);
#pragma unroll
        for (int j = 0; j < 8; ++j) {
            const int col = 4 * (C.lane + 64 * j);
            const f32x4 y = v[j] * rstd;
            { const f32x4 g = *(const f32x4*)(g1 + col), sh = *(const f32x4*)(sh1 + (size_t)b * mstride1 + col), sc = *(const f32x4*)(sc1 + (size_t)b * mstride1 + col);
              const f32x4 h = (y * g) * (sc + 1.0f) + sh; v2u w; w.x = pk2(h.x, h.y); w.y = pk2(h.z, h.w); *(GAS v2u*)(o1 + (size_t)m * DM + col) = w; }
            if (DUAL) { const f32x4 g = *(const f32x4*)(g2 + col), sh = *(const f32x4*)(sh2 + (size_t)b * mstride2 + col), sc = *(const f32x4*)(sc2 + (size_t)b * mstride2 + col);
              const f32x4 h = (y * g) * (sc + 1.0f) + sh; v2u w; w.x = pk2(h.x, h.y); w.y = pk2(h.z, h.w); *(GAS v2u*)(o2 + (size_t)m * DM + col) = w; }
        }
    }
}
__device__ __forceinline__ void phase_rms512(const Ctx& C, const float* src, int ld, const float* gain, bf16* out) {
    const int gw = C.vcu * NWAVES + C.wave, NGW = C.G * NWAVES;
    const f32x4 g0 = *(const f32x4*)(gain + 4 * C.lane), g1 = *(const f32x4*)(gain + 256 + 4 * C.lane);
    for (int m = gw; m < MTOK; m += NGW) {
        const f32x4* r = (const f32x4*)(src + (size_t)m * ld) + C.lane;
        const f32x4 v0 = r[0], v1 = r[64];
        const float s = (v0.x * v0.x + v0.y * v0.y) + (v0.z * v0.z + v0.w * v0.w) + (v1.x * v1.x + v1.y * v1.y) + (v1.z * v1.z + v1.w * v1.w);
        const float rstd = 1.0f / sqrtf(wave_sum(s) * (1.0f / 512.0f) + EPS);
        const f32x4 a = v0 * rstd * g0, b = v1 * rstd * g1;
        v2u w0, w1; w0.x = pk2(a.x, a.y); w0.y = pk2(a.z, a.w); w1.x = pk2(b.x, b.y); w1.y = pk2(b.z, b.w);
        *(GAS v2u*)(out + (size_t)m * 512 + 4 * C.lane) = w0; *(GAS v2u*)(out + (size_t)m * 512 + 256 + 4 * C.lane) = w1;
    }
}
__device__ __forceinline__ void phase_kv_build(const Ctx& C, const bf16* kvraw, const float* ckv, const float* kgain, const f32x2* rope, bf16* Kb, bf16* Vb) {
    const int gw = C.vcu * NWAVES + C.wave, NGW = C.G * NWAVES, lane = C.lane;
    const float kg0 = kgain[2 * lane], kg1 = kgain[2 * lane + 1], kgp = kgain[128 + lane];
    for (int m = gw; m < MTOK; m += NGW) {
        const int b = m >> 12, s = m & 4095;
        const float pe = ckv[(size_t)m * CKVN + 512 + lane];
        const float pss = wave_sum(pe * pe);
        const f32x2 cs = rope[(size_t)m * 32 + (lane & 31)];
        const unsigned* kr = (const unsigned*)(kvraw + (size_t)m * 4096);
#pragma unroll 4
        for (int h = 0; h < MLA_H; ++h) {
            const unsigned w = kr[h * 128 + lane], wv = kr[h * 128 + 64 + lane];
            const float k0 = bflo(w), k1 = bfhi(w);
            const float rstd = 1.0f / sqrtf((wave_sum(k0 * k0 + k1 * k1) + pss) * (1.0f / 192.0f) + EPS);
            bf16* ko = Kb + ((size_t)(b * MLA_H + h) * SEQ + s) * QKD;
            *(GAS unsigned*)(ko + 2 * lane) = pk2(k0 * rstd * kg0, k1 * rstd * kg1);
            const float pn = pe * rstd * kgp, other = xor32(pn, lane);
            const float ro = lane < 32 ? pn * cs.x - other * cs.y : pn * cs.x + other * cs.y;
            *(GAS unsigned short*)(ko + 128 + lane) = (unsigned short)f2bf(ro);
            *(GAS unsigned*)(Vb + ((size_t)(b * MLA_H + h) * SEQ + s) * VDIM + 2 * lane) = wv;
        }
    }
}
__device__ __forceinline__ void phase_q_post(const Ctx& C, bf16* Q, const float* qgain, const f32x2* rope) {
    const int gw = C.vcu * NWAVES + C.wave, NGW = C.G * NWAVES, lane = C.lane;
    const float g0 = qgain[2 * lane], g1 = qgain[2 * lane + 1], gp = qgain[128 + lane];
    for (int m = gw; m < MTOK; m += NGW) {
        const f32x2 cs = rope[(size_t)m * 32 + (lane & 31)];
        bf16* qr = Q + (size_t)m * 3072;
#pragma unroll 4
        for (int h = 0; h < MLA_H; ++h) {
            bf16* qh = qr + h * QKD;
            const unsigned w = *(const GAS unsigned*)(qh + 2 * lane); const float pe = bflo((unsigned)*(const GAS unsigned short*)(qh + 128 + lane));
            const float q0 = bflo(w), q1 = bfhi(w);
            const float rstd = 1.0f / sqrtf(wave_sum(q0 * q0 + q1 * q1 + pe * pe) * (1.0f / 192.0f) + EPS);
            *(GAS unsigned*)(qh + 2 * lane) = pk2(q0 * rstd * g0, q1 * rstd * g1);
            const float pn = pe * rstd * gp, other = xor32(pn, lane);
            const float ro = lane < 32 ? pn * cs.x - other * cs.y : pn * cs.x + other * cs.y;
            *(GAS unsigned short*)(qh + 128 + lane) = (unsigned short)f2bf(ro);
        }
    }
}

__device__ __forceinline__ void phase_hgrn_simple(const Ctx& C, const Args& a, int layer, const bf16* proj, bf16* Hout) {
    LAS float* fA = (LAS float*)(C.lds + RING_OFF);
    LAS float* kA = fA + 32 * 128; LAS float* qA = kA + 32 * 128; LAS float* vA = qA + 32 * 128; LAS float* oA = vA + 32 * 128;
    const int tid = C.tid, st = tid >> 4, sc8 = (tid & 15) * 8, j = tid >> 2, qd = tid & 3;
    for (int unit = C.vcu; unit < NBATCH * HG_H; unit += C.G) {
        const int b = unit >> 4, h = unit & 15;
        float lb[8], og[8];
#pragma unroll
        for (int e = 0; e < 8; ++e) { const int c = h * 128 + sc8 + e; const float a0 = a.hg_lower[c], a1 = a.hg_lower[DM + c], a2 = a.hg_lower[2 * DM + c];
            const float mx = fmaxf(a0, fmaxf(a1, a2)), e0 = expf(a0 - mx), e1 = expf(a1 - mx), e2 = expf(a2 - mx), inv = 1.0f / (e0 + e1 + e2);
            lb[e] = (layer == 0) ? e0 * inv : (e0 + e1) * inv; og[e] = a.hg_o_norm[layer * HG_D + sc8 + e]; }
        float S[32];
#pragma unroll
        for (int i = 0; i < 32; ++i) S[i] = 0.f;
        for (int c0 = 0; c0 < SEQ; c0 += 32) {
            const size_t row = (size_t)b * SEQ + c0 + st;
            const bf16* pr = proj + row * (4 * DM) + h * 128 + sc8;
            const v4u q8 = *(const GAS v4u*)pr, z8 = *(const GAS v4u*)(pr + DM), v8 = *(const GAS v4u*)(pr + 2 * DM);
            {
                float qf[8], zf[8], vf[8];
#pragma unroll
                for (int e = 0; e < 4; ++e) { qf[2 * e] = bflo(q8[e]); qf[2 * e + 1] = bfhi(q8[e]); zf[2 * e] = bflo(z8[e]); zf[2 * e + 1] = bfhi(z8[e]); vf[2 * e] = bflo(v8[e]); vf[2 * e + 1] = bfhi(v8[e]); }
                float ff[8], kf[8];
#pragma unroll
                for (int e = 0; e < 8; ++e) { const float sg = 1.0f / (1.0f + __expf(-zf[e])); ff[e] = lb[e] + (1.0f - lb[e]) * sg; kf[e] = (1.0f - lb[e]) * (1.0f - sg); qf[e] *= 0.08838834764831845f; }
                const int o = st * 128 + sc8;
                *(LAS f32x4*)(fA + o) = (f32x4){ff[0], ff[1], ff[2], ff[3]}; *(LAS f32x4*)(fA + o + 4) = (f32x4){ff[4], ff[5], ff[6], ff[7]};
                *(LAS f32x4*)(kA + o) = (f32x4){kf[0], kf[1], kf[2], kf[3]}; *(LAS f32x4*)(kA + o + 4) = (f32x4){kf[4], kf[5], kf[6], kf[7]};
                *(LAS f32x4*)(qA + o) = (f32x4){qf[0], qf[1], qf[2], qf[3]}; *(LAS f32x4*)(qA + o + 4) = (f32x4){qf[4], qf[5], qf[6], qf[7]};
                *(LAS f32x4*)(vA + o) = (f32x4){vf[0], vf[1], vf[2], vf[3]}; *(LAS f32x4*)(vA + o + 4) = (f32x4){vf[4], vf[5], vf[6], vf[7]};
            }
            __syncthreads();
            for (int t = 0; t < 32; ++t) {
                const float vj = vA[t * 128 + j];
                float part = 0.f;
#pragma unroll
                for (int i4 = 0; i4 < 8; ++i4) {
                    const f32x4 f4 = *(const LAS f32x4*)(fA + t * 128 + qd * 32 + i4 * 4), k4 = *(const LAS f32x4*)(kA + t * 128 + qd * 32 + i4 * 4), q4 = *(const LAS f32x4*)(qA + t * 128 + qd * 32 + i4 * 4);
#pragma unroll
                    for (int e = 0; e < 4; ++e) { S[i4 * 4 + e] = fmaf(f4[e], S[i4 * 4 + e], k4[e] * vj); part = fmaf(q4[e], S[i4 * 4 + e], part); }
                }
                part += xor_f<1>(part); part += xor_f<2>(part);
                if (qd == 0) oA[t * 128 + j] = part;
            }
            __syncthreads();
            {
                const f32x4 o0 = *(const LAS f32x4*)(oA + st * 128 + sc8), o1 = *(const LAS f32x4*)(oA + st * 128 + sc8 + 4);
                float ss = (o0.x * o0.x + o0.y * o0.y) + (o0.z * o0.z + o0.w * o0.w) + (o1.x * o1.x + o1.y * o1.y) + (o1.z * o1.z + o1.w * o1.w);
                ss += xor_f<1>(ss); ss += xor_f<2>(ss); ss += xor_f<4>(ss); ss += xor_f<8>(ss);
                const float rstd = 1.0f / sqrtf(ss * (1.0f / 128.0f) + EPS);
                const v4u g8 = *(const GAS v4u*)(pr + 3 * DM);
                const float ov[8] = {o0.x, o0.y, o0.z, o0.w, o1.x, o1.y, o1.z, o1.w};
                float r[8];
#pragma unroll
                for (int e = 0; e < 8; ++e) { const float g = (e & 1) ? bfhi(g8[e >> 1]) : bflo(g8[e >> 1]); const float sl = g / (1.0f + __expf(-g));
                    r[e] = ov[e] * rstd * og[e] * sl; }
                v4u w; w.x = pk2(r[0], r[1]); w.y = pk2(r[2], r[3]); w.z = pk2(r[4], r[5]); w.w = pk2(r[6], r[7]);
                *(GAS v4u*)(Hout + row * DM + h * 128 + sc8) = w;
            }
        }
        __syncthreads();
    }
}

namespace hg {
constexpr int STR = 272, TSTR = 144;
constexpr int OFF_QT = 0, OFF_KT = 17408, OFF_KTT = 34816, OFF_VT = 53248, OFF_ST = 71680, OFF_G = 106496, OFF_TS = 123904, OFF_VEC = 128000, OFF_SS = 129536;
static_assert(OFF_SS + 1024 <= RING_BYTES, "hgrn LDS map");
typedef __bf16 bf16x2_t __attribute__((ext_vector_type(2)));
__device__ __forceinline__ unsigned cvtpk_s(float lo, float hi) { f32x2 v = {lo, hi}; bf16x2_t b = __builtin_convertvector(v, bf16x2_t); return __builtin_bit_cast(unsigned, b); }
template <int SP> __device__ __forceinline__ bf16x8 pack_step(const f32x16& x) {
    v4u p; p.x = cvtpk_s(x[8 * SP], x[8 * SP + 1]); p.y = cvtpk_s(x[8 * SP + 2], x[8 * SP + 3]); p.z = cvtpk_s(x[8 * SP + 4], x[8 * SP + 5]); p.w = cvtpk_s(x[8 * SP + 6], x[8 * SP + 7]);
    return __builtin_bit_cast(bf16x8, p);
}
#define HG_MFMA(a, b, c) __builtin_amdgcn_mfma_f32_32x32x16_bf16((a), (b), (c), 0, 0, 0)
__device__ __forceinline__ void phase_hgrn(const Ctx& C, const Args& a, int layer, const bf16* proj, bf16* Hout) {
    LAS char* L = (LAS char*)C.lds;
    const int tid = C.tid, lane = C.lane, w = C.wave, l32 = lane & 31, hi = lane >> 5;
    const int k0 = 2 * lane, rg = w;
    const int dvb = w & 3, tb = w >> 2, dkb = w >> 1, dvh = w & 1;
    for (int unit = blockIdx.x; unit < NBATCH * HG_H; unit += C.G) {
        const int b = unit >> 4, h = unit & 15;
        float lb0, lb1;
        { const int c = h * 128 + k0;
          { const float a0 = a.hg_lower[c], a1 = a.hg_lower[DM + c], a2 = a.hg_lower[2 * DM + c]; const float mx = fmaxf(a0, fmaxf(a1, a2)), e0 = expf(a0 - mx), e1 = expf(a1 - mx), e2 = expf(a2 - mx), inv = 1.0f / (e0 + e1 + e2); lb0 = (layer == 0) ? e0 * inv : (e0 + e1) * inv; }
          { const float a0 = a.hg_lower[c + 1], a1 = a.hg_lower[DM + c + 1], a2 = a.hg_lower[2 * DM + c + 1]; const float mx = fmaxf(a0, fmaxf(a1, a2)), e0 = expf(a0 - mx), e1 = expf(a1 - mx), e2 = expf(a2 - mx), inv = 1.0f / (e0 + e1 + e2); lb1 = (layer == 0) ? e0 * inv : (e0 + e1) * inv; } }
        if (tid < 128) *(LAS float*)(L + OFF_VEC + 1024 + tid * 4) = a.hg_o_norm[layer * HG_D + tid];
        f32x16 S0, S1;
#pragma unroll
        for (int r = 0; r < 16; ++r) { S0[r] = 0.f; S1[r] = 0.f; }
        unsigned rq[8], rz[8], rv[8], rgt[8];
        const bf16* pbase = proj + ((size_t)b * SEQ + 8 * rg) * (4 * DM) + h * 128 + k0;
#define HG_LOAD(c0_) do { const bf16* p_ = pbase + (size_t)(c0_) * (4 * DM); _Pragma("unroll") for (int r = 0; r < 8; ++r) { \
            rq[r] = *(const GAS unsigned*)(p_ + (size_t)r * (4 * DM)); rz[r] = *(const GAS unsigned*)(p_ + (size_t)r * (4 * DM) + DM); \
            rv[r] = *(const GAS unsigned*)(p_ + (size_t)r * (4 * DM) + 2 * DM); rgt[r] = *(const GAS unsigned*)(p_ + (size_t)r * (4 * DM) + 3 * DM); } } while (0)
        HG_LOAD(0);
        for (int c0 = 0; c0 < SEQ; c0 += 64) {
            float ca[8], cb[8], ka[8], kb[8];
            { float s0 = 0.f, s1 = 0.f;
#pragma unroll
              for (int r = 0; r < 8; ++r) {
                  const float z0 = bflo(rz[r]), z1 = bfhi(rz[r]);
                  const float g0 = 1.0f / (1.0f + __expf(-z0)), g1 = 1.0f / (1.0f + __expf(-z1));
                  const float f0 = lb0 + (1.0f - lb0) * g0, f1 = lb1 + (1.0f - lb1) * g1;
                  s0 += __logf(f0); s1 += __logf(f1); ca[r] = s0; cb[r] = s1;
                  ka[r] = (1.0f - lb0) * (1.0f - g0); kb[r] = (1.0f - lb1) * (1.0f - g1);
                  const float x0 = bflo(rgt[r]), x1 = bfhi(rgt[r]);
                  *(LAS unsigned*)(L + OFF_G + (8 * rg + r) * STR + k0 * 2) = cvtpk_s(x0 / (1.0f + __expf(-x0)), x1 / (1.0f + __expf(-x1)));
              }
              *(LAS f32x2*)(L + OFF_TS + (rg * 128 + k0) * 4) = (f32x2){s0, s1};
              v4u lo, hi4;
              lo.x = (rv[0] & 0xffffu) | (rv[1] << 16); lo.y = (rv[2] & 0xffffu) | (rv[3] << 16); lo.z = (rv[4] & 0xffffu) | (rv[5] << 16); lo.w = (rv[6] & 0xffffu) | (rv[7] << 16);
              hi4.x = (rv[0] >> 16) | (rv[1] & 0xffff0000u); hi4.y = (rv[2] >> 16) | (rv[3] & 0xffff0000u); hi4.z = (rv[4] >> 16) | (rv[5] & 0xffff0000u); hi4.w = (rv[6] >> 16) | (rv[7] & 0xffff0000u);
              *(LAS v4u*)(L + OFF_VT + k0 * TSTR + rg * 16) = lo; *(LAS v4u*)(L + OFF_VT + (k0 + 1) * TSTR + rg * 16) = hi4; }
            __syncthreads();
            { float P0 = 0.f, P1 = 0.f, R0 = 0.f, R1 = 0.f, T0 = 0.f, T1 = 0.f;
#pragma unroll
              for (int g = 0; g < 8; ++g) { const f32x2 t2 = *(const LAS f32x2*)(L + OFF_TS + (g * 128 + k0) * 4);
                  P0 += (g < rg) ? t2.x : 0.f; P1 += (g < rg) ? t2.y : 0.f; if (g < 4) { R0 += t2.x; R1 += t2.y; } T0 += t2.x; T1 += t2.y; }
              unsigned kt[8];
#pragma unroll
              for (int r = 0; r < 8; ++r) {
                  const float b0 = P0 + ca[r] - R0, b1 = P1 + cb[r] - R1;
                  const float q0 = bflo(rq[r]) * 0.08838834764831845f * __expf(b0), q1 = bfhi(rq[r]) * 0.08838834764831845f * __expf(b1);
                  *(LAS unsigned*)(L + OFF_QT + (8 * rg + r) * STR + k0 * 2) = cvtpk_s(q0, q1);
                  kt[r] = cvtpk_s(ka[r] * __expf(-b0), kb[r] * __expf(-b1));
                  *(LAS unsigned*)(L + OFF_KT + (8 * rg + r) * STR + k0 * 2) = kt[r];
              }
              v4u lo, hi4;
              lo.x = (kt[0] & 0xffffu) | (kt[1] << 16); lo.y = (kt[2] & 0xffffu) | (kt[3] << 16); lo.z = (kt[4] & 0xffffu) | (kt[5] << 16); lo.w = (kt[6] & 0xffffu) | (kt[7] << 16);
              hi4.x = (kt[0] >> 16) | (kt[1] & 0xffff0000u); hi4.y = (kt[2] >> 16) | (kt[3] & 0xffff0000u); hi4.z = (kt[4] >> 16) | (kt[5] & 0xffff0000u); hi4.w = (kt[6] >> 16) | (kt[7] & 0xffff0000u);
              *(LAS v4u*)(L + OFF_KTT + k0 * TSTR + rg * 16) = lo; *(LAS v4u*)(L + OFF_KTT + (k0 + 1) * TSTR + rg * 16) = hi4;
              if (rg == 0) { *(LAS f32x2*)(L + OFF_VEC + k0 * 4) = (f32x2){__expf(R0), __expf(R1)}; *(LAS f32x2*)(L + OFF_VEC + 512 + k0 * 4) = (f32x2){__expf(T0 - R0), __expf(T1 - R1)}; } }
            if (c0 + 64 < SEQ) HG_LOAD(c0 + 64);
            __syncthreads();
            bf16x8 qf[8];
            f32x16 D0, D1;
#pragma unroll
            for (int r = 0; r < 16; ++r) { D0[r] = 0.f; D1[r] = 0.f; }
            { const LAS char* qrow = L + OFF_QT + (32 * tb + l32) * STR + hi * 16;
#pragma unroll
              for (int st = 0; st < 8; ++st) qf[st] = *(const LAS bf16x8*)(qrow + st * 32);
              const LAS char* krow = L + OFF_KT + l32 * STR + hi * 16;
#pragma unroll
              for (int st = 0; st < 8; ++st) D0 = HG_MFMA(*(const LAS bf16x8*)(krow + st * 32), qf[st], D0);
              if (tb == 1) {
#pragma unroll
                  for (int st = 0; st < 8; ++st) D1 = HG_MFMA(*(const LAS bf16x8*)(krow + 32 * STR + st * 32), qf[st], D1);
              }
#pragma unroll
              for (int r = 0; r < 16; ++r) { const bool keep = ((r & 3) + 8 * (r >> 2) + 4 * hi) <= l32; if (tb == 0) D0[r] = keep ? D0[r] : 0.f; else D1[r] = keep ? D1[r] : 0.f; } }
#pragma unroll
            for (int g4 = 0; g4 < 4; ++g4) { const f32x4 e4 = *(const LAS f32x4*)(L + OFF_VEC + (32 * dkb + 8 * g4 + 4 * hi) * 4);
#pragma unroll
                for (int j = 0; j < 4; ++j) { S0[4 * g4 + j] *= e4[j]; S1[4 * g4 + j] *= e4[j]; }
                v2u w0, w1; w0.x = cvtpk_s(S0[4 * g4], S0[4 * g4 + 1]); w0.y = cvtpk_s(S0[4 * g4 + 2], S0[4 * g4 + 3]); w1.x = cvtpk_s(S1[4 * g4], S1[4 * g4 + 1]); w1.y = cvtpk_s(S1[4 * g4 + 2], S1[4 * g4 + 3]);
                *(LAS v2u*)(L + OFF_ST + (64 * dvh + l32) * STR + (32 * dkb + 8 * g4 + 4 * hi) * 2) = w0;
                *(LAS v2u*)(L + OFF_ST + (64 * dvh + 32 + l32) * STR + (32 * dkb + 8 * g4 + 4 * hi) * 2) = w1; }
            __syncthreads();
            f32x16 O;
#pragma unroll
            for (int r = 0; r < 16; ++r) O[r] = 0.f;
            { const LAS char* vrow = L + OFF_VT + (32 * dvb + l32) * TSTR + hi * 8;
#define HG_PV(D, sb, sp) do { const s16x4 lo_ = *(const LAS s16x4*)(vrow + (32 * (sb) + 16 * (sp)) * 2), hi_ = *(const LAS s16x4*)(vrow + (32 * (sb) + 16 * (sp) + 8) * 2); \
                O = HG_MFMA(__builtin_shufflevector(lo_, hi_, 0, 1, 2, 3, 4, 5, 6, 7), pack_step<sp>(D), O); } while (0)
              HG_PV(D0, 0, 0); HG_PV(D0, 0, 1);
              if (tb == 1) { HG_PV(D1, 1, 0); HG_PV(D1, 1, 1); }
#undef HG_PV
              const LAS char* srow = L + OFF_ST + (32 * dvb + l32) * STR + hi * 16;
#pragma unroll
              for (int kk = 0; kk < 8; ++kk) O = HG_MFMA(*(const LAS bf16x8*)(srow + kk * 32), qf[kk], O); }
            { const LAS char* arow = L + OFF_KTT + (32 * dkb + l32) * TSTR + hi * 16;
              const LAS char* b0row = L + OFF_VT + (64 * dvh + l32) * TSTR + hi * 16;
#pragma unroll
              for (int st = 0; st < 4; ++st) { const bf16x8 A = *(const LAS bf16x8*)(arow + st * 32);
                  S0 = HG_MFMA(A, *(const LAS bf16x8*)(b0row + st * 32), S0); S1 = HG_MFMA(A, *(const LAS bf16x8*)(b0row + 32 * TSTR + st * 32), S1); }
#pragma unroll
              for (int g4 = 0; g4 < 4; ++g4) { const f32x4 e4 = *(const LAS f32x4*)(L + OFF_VEC + 512 + (32 * dkb + 8 * g4 + 4 * hi) * 4);
#pragma unroll
                  for (int j = 0; j < 4; ++j) { S0[4 * g4 + j] *= e4[j]; S1[4 * g4 + j] *= e4[j]; } } }
            { float ss = 0.f;
#pragma unroll
              for (int r = 0; r < 16; ++r) ss = fmaf(O[r], O[r], ss);
              ss += xor32(ss, lane);
              if (hi == 0) *(LAS float*)(L + OFF_SS + (dvb * 64 + 32 * tb + l32) * 4) = ss; }
            __syncthreads();
            { const int t = 32 * tb + l32;
              const float tot = *(const LAS float*)(L + OFF_SS + t * 4) + *(const LAS float*)(L + OFF_SS + (64 + t) * 4) + *(const LAS float*)(L + OFF_SS + (128 + t) * 4) + *(const LAS float*)(L + OFF_SS + (192 + t) * 4);
              const float rstd = 1.0f / sqrtf(tot * (1.0f / 128.0f) + EPS);
#pragma unroll
              for (int g4 = 0; g4 < 4; ++g4) { const int dv = 32 * dvb + 8 * g4 + 4 * hi;
                  const f32x4 og4 = *(const LAS f32x4*)(L + OFF_VEC + 1024 + dv * 4); const v2u gw = *(const LAS v2u*)(L + OFF_G + t * STR + dv * 2);
                  v2u o2; o2.x = cvtpk_s(O[4 * g4] * rstd * og4[0] * bflo(gw.x), O[4 * g4 + 1] * rstd * og4[1] * bfhi(gw.x));
                  o2.y = cvtpk_s(O[4 * g4 + 2] * rstd * og4[2] * bflo(gw.y), O[4 * g4 + 3] * rstd * og4[3] * bfhi(gw.y));
                  *(LAS v2u*)(L + OFF_KT + t * STR + dv * 2) = o2; } }
            __syncthreads();
            { const int row = tid >> 4, c8 = (tid & 15) * 8;
              bf16* op = Hout + ((size_t)b * SEQ + c0 + row) * DM + h * 128 + c8;
              *(GAS v4u*)op = *(const LAS v4u*)(L + OFF_KT + row * STR + c8 * 2);
              *(GAS v4u*)(op + (size_t)32 * DM) = *(const LAS v4u*)(L + OFF_KT + (row + 32) * STR + c8 * 2); }
        }
        __syncthreads();
#undef HG_LOAD
    }
}
#undef HG_MFMA
}

namespace att {
constexpr int KROW = 400;
constexpr int SHM_K = 64 * KROW;
constexpr int SHM_V = 64 * 128 * 2;
constexpr int V_OFF = 0, K_OFF = 2 * SHM_V, WS_OFF = K_OFF + 2 * SHM_K;
constexpr float SCALE = 0.07216878364870322f;
constexpr float THR = 8.f;
#define SBAR() __builtin_amdgcn_sched_barrier(0)
__device__ __forceinline__ int v_st(int k, int c) { const int kk = (k & ~0xC) | ((k & 4) << 1) | ((k & 8) >> 1); return ((kk >> 3) * 4 + (c >> 5)) * 512 + ((kk & 7) * 32 + (c & 31)) * 2; }
__device__ __forceinline__ int v_rd_base(int lane) { return ((lane & 3) << 3) | (((lane >> 2) & 3) << 6) | (((lane >> 4) & 1) << 5) | (((lane >> 5) & 1) << 8); }
constexpr int v_rd_off(int d0, int ks, int half) { return d0 * 512 + ks * 4096 + half * 2048; }
__device__ __forceinline__ int crow(int r, int hi) { return (r & 3) + 8 * (r >> 2) + 4 * hi; }
__device__ __forceinline__ unsigned cvtpk(float lo, float hi) { unsigned r; asm volatile("v_cvt_pk_bf16_f32 %0, %1, %2" : "=v"(r) : "v"(lo), "v"(hi)); return r; }

__device__ __forceinline__ void mask_tile(f32x16& p0, f32x16& p1, int dq) {
    const float NEG = -__builtin_inff();
#pragma unroll
    for (int r = 0; r < 16; ++r) {
        const int c = (r & 3) + 8 * (r >> 2);
        if (dq - c < 0) p0[r] = NEG;
        if (dq - c - 32 < 0) p1[r] = NEG;
    }
}
__device__ __forceinline__ void partialSM(f32x16& p0, f32x16& p1, float& m_reg, float& mn, float& alpha) {
    float pmax = p0[0];
#pragma unroll
    for (int r = 1; r < 16; ++r) pmax = fmaxf(pmax, p0[r]);
#pragma unroll
    for (int r = 0; r < 16; ++r) pmax = fmaxf(pmax, p1[r]);
    { auto rr = __builtin_amdgcn_permlane32_swap(__float_as_uint(pmax), __float_as_uint(pmax), false, false);
      pmax = fmaxf(__uint_as_float(rr[0]), __uint_as_float(rr[1])); }
    constexpr float C2 = 1.4426950408889634f * SCALE;
    if (__builtin_expect(__all((pmax - m_reg) * SCALE <= THR), 1)) { mn = m_reg; alpha = 1.f; }
    else { mn = fmaxf(m_reg, pmax); alpha = __builtin_amdgcn_exp2f((m_reg - mn) * C2); m_reg = mn; }
    const float mnL = -mn * C2;
#pragma unroll
    for (int r = 0; r < 16; ++r) p0[r] = fmaf(p0[r], C2, mnL);
#pragma unroll
    for (int r = 0; r < 16; ++r) p1[r] = fmaf(p1[r], C2, mnL);
#pragma unroll
    for (int r = 0; r < 16; ++r) p0[r] = __builtin_amdgcn_exp2f(p0[r]);
}
__device__ __forceinline__ void finishSM(f32x16& p0, f32x16& p1, float alpha, float& l_reg, bf16x8& pa0, bf16x8& pa1, bf16x8& pa2, bf16x8& pa3) {
#pragma unroll
    for (int r = 0; r < 16; ++r) p1[r] = __builtin_amdgcn_exp2f(p1[r]);
    float ps = 0;
#pragma unroll
    for (int r = 0; r < 16; ++r) ps += p0[r];
#pragma unroll
    for (int r = 0; r < 16; ++r) ps += p1[r];
    { auto rr = __builtin_amdgcn_permlane32_swap(__float_as_uint(ps), __float_as_uint(ps), false, false);
      ps = __uint_as_float(rr[0]) + __uint_as_float(rr[1]); }
    l_reg = l_reg * alpha + ps;
#define PK4(P, B_, OUT) do { unsigned a0 = cvtpk(P[B_+0], P[B_+1]), a1 = cvtpk(P[B_+2], P[B_+3]);                          \
        unsigned b0 = cvtpk(P[B_+4], P[B_+5]), b1 = cvtpk(P[B_+6], P[B_+7]);                                             \
        auto r0 = __builtin_amdgcn_permlane32_swap(a0, b0, false, false); auto r1 = __builtin_amdgcn_permlane32_swap(a1, b1, false, false); \
        v4u w = {r0[0], r1[0], r0[1], r1[1]}; OUT = __builtin_bit_cast(bf16x8, w); } while (0)
    PK4(p0, 0, pa0); PK4(p0, 8, pa1); PK4(p1, 0, pa2); PK4(p1, 8, pa3);
#undef PK4
}
template <int KB>
__device__ __forceinline__ void qkt(f32x16& p0, f32x16& p1, const LAS char* lds, int kbase, const bf16x8* qr) {
#pragma unroll
    for (int r = 0; r < 16; ++r) { p0[r] = 0.f; p1[r] = 0.f; }
    const LAS char* a = lds + K_OFF + KB * SHM_K + kbase;
#pragma unroll
    for (int d0 = 0; d0 < 12; ++d0) {
        const bf16x8 b0 = *(const LAS bf16x8*)(a + d0 * 32);
        const bf16x8 b1 = *(const LAS bf16x8*)(a + d0 * 32 + 32 * KROW);
        p0 = __builtin_amdgcn_mfma_f32_32x32x16_bf16(b0, qr[d0], p0, 0, 0, 0);
        p1 = __builtin_amdgcn_mfma_f32_32x32x16_bf16(b1, qr[d0], p1, 0, 0, 0); }
}
template <int VB>
__device__ __forceinline__ void pv_tile(f32x16* o, int vb0, bf16x8 pa0, bf16x8 pa1, bf16x8 pa2, bf16x8 pa3) {
#define TRRD(dst, off) asm volatile("ds_read_b64_tr_b16 %0, %1 offset:%2" : "=&v"(dst) : "v"(vb0), "i"(off) : "memory")
#define PV_D0(d0) do { s16x4 l0, l1, l2, l3, h0, h1, h2, h3; constexpr int b_ = V_OFF + VB * SHM_V + v_rd_off(d0, 0, 0); \
        TRRD(l0, b_); TRRD(h0, b_ + 2048); TRRD(l1, b_ + 4096); TRRD(h1, b_ + 6144); TRRD(l2, b_ + 8192); TRRD(h2, b_ + 10240); TRRD(l3, b_ + 12288); TRRD(h3, b_ + 14336); \
        asm volatile("s_waitcnt lgkmcnt(0)" ::: "memory"); SBAR();   \
        o[d0] = __builtin_amdgcn_mfma_f32_32x32x16_bf16(pa0, (bf16x8){l0[0], l0[1], l0[2], l0[3], h0[0], h0[1], h0[2], h0[3]}, o[d0], 0, 0, 0);   \
        o[d0] = __builtin_amdgcn_mfma_f32_32x32x16_bf16(pa1, (bf16x8){l1[0], l1[1], l1[2], l1[3], h1[0], h1[1], h1[2], h1[3]}, o[d0], 0, 0, 0);   \
        o[d0] = __builtin_amdgcn_mfma_f32_32x32x16_bf16(pa2, (bf16x8){l2[0], l2[1], l2[2], l2[3], h2[0], h2[1], h2[2], h2[3]}, o[d0], 0, 0, 0);   \
        o[d0] = __builtin_amdgcn_mfma_f32_32x32x16_bf16(pa3, (bf16x8){l3[0], l3[1], l3[2], l3[3], h3[0], h3[1], h3[2], h3[3]}, o[d0], 0, 0, 0); } while (0)
    PV_D0(0); PV_D0(1); PV_D0(2); PV_D0(3);
#undef PV_D0
#undef TRRD
}

__device__ __forceinline__ void attn_block(const Ctx& C, int b, int h, int qb, const bf16* Q, const bf16* Kb, const bf16* Vb, bf16* O) {
    const int tid = C.tid, wid = C.wave, lane = C.lane, r32 = lane & 31, hi = lane >> 5;
    const LAS char* lds = (const LAS char*)C.lds;
    LAS char* ldsw = (LAS char*)C.lds;
    const int P0 = qb * 256, qlo = P0 + wid * 32, NT = (P0 + 256) / 64;
    const bf16* Kh = Kb + (size_t)(b * MLA_H + h) * SEQ * QKD;
    const bf16* Vh = Vb + (size_t)(b * MLA_H + h) * SEQ * VDIM;
    bf16x8 qr[12];
    { const bf16* qp = Q + (size_t)(b * SEQ + qlo + r32) * 3072 + h * QKD + hi * 8;
#pragma unroll
      for (int d0 = 0; d0 < 12; ++d0) qr[d0] = *(const GAS bf16x8*)(qp + d0 * 16); }
    LAS float* wsf = (LAS float*)(ldsw + WS_OFF) + wid * 64; LAS float* li_l = wsf; LAS float* al_l = wsf + 32;
    float m_reg = -1e30f, l_reg = 0.f; f32x16 o[4];
#pragma unroll
    for (int d = 0; d < 4; ++d)
#pragma unroll
        for (int r = 0; r < 16; ++r) o[d][r] = 0.f;
    int kdst[3];
#pragma unroll
    for (int i = 0; i < 3; ++i) { const int c = tid + 512 * i; kdst[i] = (c / 24) * KROW + (c % 24) * 16; }
    const int sr = tid >> 4, sc = (tid & 15) * 8, vst0 = v_st(sr, sc), vst1 = v_st(32 + sr, sc);
    const int kbase = r32 * KROW + hi * 16;
    const int vb0 = (int)(unsigned)(uintptr_t)(ldsw) + v_rd_base(lane);
    const int qm = qlo + r32 - 4 * hi;
    bf16x8 sk0, sk1, sk2, sv0, sv1;
#define A_LOAD(t) do { const bf16* kp = Kh + (size_t)(t) * 64 * QKD + tid * 8; sk0 = *(const GAS bf16x8*)kp; sk1 = *(const GAS bf16x8*)(kp + 4096); sk2 = *(const GAS bf16x8*)(kp + 8192); \
        const bf16* vp = Vh + (size_t)((t) * 64 + sr) * VDIM + sc; sv0 = *(const GAS bf16x8*)vp; sv1 = *(const GAS bf16x8*)(vp + 32 * VDIM); } while (0)
#define A_WRITE(bf) do { *(LAS bf16x8*)(ldsw + K_OFF + (bf) * SHM_K + kdst[0]) = sk0; *(LAS bf16x8*)(ldsw + K_OFF + (bf) * SHM_K + kdst[1]) = sk1; *(LAS bf16x8*)(ldsw + K_OFF + (bf) * SHM_K + kdst[2]) = sk2; \
        *(LAS bf16x8*)(ldsw + V_OFF + (bf) * SHM_V + vst0) = sv0; *(LAS bf16x8*)(ldsw + V_OFF + (bf) * SHM_V + vst1) = sv1; } while (0)
#define RESC(aa) do { if (__any((aa) < 1.f)) { if (hi == 0) al_l[r32] = (aa); asm volatile("s_waitcnt lgkmcnt(0)" ::: "memory");              \
        _Pragma("unroll") for (int d_ = 0; d_ < 4; ++d_) _Pragma("unroll") for (int r = 0; r < 16; ++r) o[d_][r] *= al_l[crow(r, hi)]; } } while (0)
#define A_COMPUTE(t, BF) do { const int kb_ = (t) * 64; if (kb_ <= qlo + 31) { f32x16 p0, p1; float mn, al; bf16x8 pa0, pa1, pa2, pa3;   \
        qkt<BF>(p0, p1, lds, kbase, qr);                                              \
        if (kb_ + 63 > qlo) mask_tile(p0, p1, qm - kb_);                               \
        partialSM(p0, p1, m_reg, mn, al); finishSM(p0, p1, al, l_reg, pa0, pa1, pa2, pa3); RESC(al); SBAR();  \
        pv_tile<BF>(o, vb0, pa0, pa1, pa2, pa3); } } while (0)
    A_LOAD(0); VM_WAIT(); A_WRITE(0); __syncthreads();
    for (int t = 0; t < NT; t += 2) {
        A_LOAD(t + 1);
        A_COMPUTE(t, 0);
        VM_WAIT(); A_WRITE(1); __syncthreads();
        if (t + 2 < NT) A_LOAD(t + 2);
        A_COMPUTE(t + 1, 1);
        if (t + 2 < NT) { VM_WAIT(); A_WRITE(0); }
        __syncthreads();
    }
    if (hi == 0) li_l[r32] = l_reg;
    asm volatile("s_waitcnt lgkmcnt(0)" ::: "memory");
    int hi_e = hi, r32_e = r32; asm volatile("" : "+v"(hi_e), "+v"(r32_e));
    bf16* Ow = O + (size_t)(b * SEQ + qlo + 4 * hi_e) * DM + h * VDIM + r32_e;
#pragma unroll
    for (int r = 0; r < 16; ++r) { const int orow = (r & 3) + 8 * (r >> 2); const float rl = __builtin_amdgcn_rcpf(li_l[orow + 4 * hi_e]);
#pragma unroll
        for (int d0 = 0; d0 < 4; ++d0) { const float v = o[d0][r] * rl; const float vn = xor_f<1>(v);
            if ((r32_e & 1) == 0) *(GAS unsigned*)(Ow + (size_t)orow * DM + d0 * 32) = cvtpk(v, vn); } }
    __syncthreads();
#undef A_LOAD
#undef A_WRITE
#undef RESC
#undef A_COMPUTE
}
__device__ __forceinline__ void attn_phase(const Ctx& C, const bf16* Q, const bf16* Kb, const bf16* Vb, bf16* O) {
    constexpr int NITEM = NBATCH * MLA_H * 8;
    for (int L = C.vcu; L < NITEM; L += C.G) {
        const int bh = L >> 3, x = L & 7;
        attn_block(C, bh >> 4, bh & 15, 15 - x, Q, Kb, Vb, O);
        attn_block(C, bh >> 4, bh & 15, x, Q, Kb, Vb, O);
    }
}
}

constexpr int NPHASES = 39;
__global__ void __launch_bounds__(NWAVES * 64, 2) fwd_kernel(Args args) {
    extern __shared__ __attribute__((aligned(16))) unsigned char lds_raw[];
    Ctx C0;
    C0.lds = (LAS unsigned char*)lds_raw;
    C0.tid = threadIdx.x; C0.lane = C0.tid & 63; C0.wave = __builtin_amdgcn_readfirstlane(C0.tid >> 6);
    C0.G = gridDim.x; { const int bx = blockIdx.x; C0.vcu = (C0.G % 8 == 0) ? (bx % 8) * (C0.G / 8) + bx / 8 : bx; }
    volatile LAS unsigned* MISC = (volatile LAS unsigned*)(C0.lds + MISC_OFF);
    unsigned char* ws = args.ws;
    gu32* ctl = (gu32*)(ws + WS_CTL);
    for (int u = C0.tid; u < (LDS_BYTES - LDSCTL_OFF) / 4; u += NWAVES * 64) ((LAS unsigned*)(C0.lds + LDSCTL_OFF))[u] = 0u;
    __syncthreads();
#if MK_MULTI
#define GRID_BAR() do { } while (0)
#else
    XcdBarrier bar = xcd_barrier_post((unsigned*)(ctl + CW_BAR), MISC + 8);
#define GRID_BAR() do { XcdBarrier b2_ = bar; asm volatile("" : "+s"(b2_.bar), "+s"(b2_.x)); xcd_barrier(b2_); } while (0)
#endif
    const int lo = args.ph_lo, hi = args.ph_hi;
    int ph = 0;
#define PHASE_BEGIN if (ph >= lo && ph < hi) { const Ctx C = fresh(C0);
#define PHASE_END   if (ph + 1 < hi) GRID_BAR(); } ++ph;

    float* const X = args.out;
    bf16* const Hb = (bf16*)(ws + WS_H);
    unsigned char* const BIG = ws + WS_BIG;
    const float* const mod = (const float*)(ws + WS_MOD);
    const float* const kvmod = (const float*)(ws + WS_KVMOD);
    const f32x2* const rope = (const f32x2*)(ws + WS_ROPE);

    PHASE_BEGIN phase_prologue(args, C); PHASE_END

    for (int layer = 0; layer < DEPTH; ++layer) {
        const float* modl = mod + (size_t)layer * NBATCH * MODW;
        const float* xin = (layer == 0) ? args.x : X;
        PHASE_BEGIN
        if (layer == NA) phase_norm_mod<true>(C, xin, args.norm_mix + layer * DM, modl, modl + DM, MODW, Hb, args.kv_in_norm, kvmod, kvmod + DM, 2 * DM, (bf16*)(BIG + BIG_HKV));
        else phase_norm_mod<false>(C, xin, args.norm_mix + layer * DM, modl, modl + DM, MODW, Hb, nullptr, nullptr, nullptr, 0, nullptr);
        PHASE_END
        if (layer < NA) {
            PHASE_BEGIN { pg8::Gemm g{Hb, (const bf16*)(ws + WS_WIN) + (size_t)layer * 4 * DM * DM, MTOK, 4 * DM, DM}; pg8::StaticOrder S; S.init(MTOK, 4 * DM, C.G, (int)blockIdx.x);
                pg8::EpiBf16<0> E{(bf16*)BIG, 4 * DM}; pg8::gemm_phase<pg8::EpiBf16<0>, pg8::StaticOrder, true, true>(C.lds + RING_OFF, g, S, E); } PHASE_END
            PHASE_BEGIN
#if defined(HGRN_SIMPLE)
            phase_hgrn_simple(C, args, layer, (const bf16*)BIG, Hb);
#else
            hg::phase_hgrn(C, args, layer, (const bf16*)BIG, Hb);
#endif
            PHASE_END
            PHASE_BEGIN { pg8::Gemm g{Hb, (const bf16*)(ws + WS_WOUT) + (size_t)layer * DM * DM, MTOK, DM, DM}; pg8::StaticOrder S; S.init(MTOK, DM, C.G, (int)blockIdx.x);
                pg8::EpiResid E{xin, X, DM, modl + 2 * DM, MODW}; pg8::gemm_phase<pg8::EpiResid, pg8::StaticOrder, true, true>(C.lds + RING_OFF, g, S, E); } PHASE_END
        } else {
            const int j = layer - NA;
            if (layer == NA) {
                PHASE_BEGIN { pg8::Gemm g{(const bf16*)(BIG + BIG_HKV), (const bf16*)(ws + WS_WDKV), MTOK, CKVN, DM}; pg8::StaticOrder S; S.init(MTOK, CKVN, C.G, (int)blockIdx.x);
                    pg8::EpiF32 E{(float*)(BIG + BIG_CKV), CKVN}; pg8::gemm_phase<pg8::EpiF32, pg8::StaticOrder, true, true>(C.lds + RING_OFF, g, S, E); } PHASE_END
                PHASE_BEGIN phase_rms512(C, (const float*)(BIG + BIG_CKV), CKVN, args.kv_norm, (bf16*)(BIG + BIG_CLAT)); PHASE_END
                PHASE_BEGIN { pg8::Gemm g{(const bf16*)(BIG + BIG_CLAT), (const bf16*)(ws + WS_WUKV), MTOK, 4096, KVLORA}; pg8::StaticOrder S; S.init(MTOK, 4096, C.G, (int)blockIdx.x);
                    pg8::EpiBf16<0> E{(bf16*)(BIG + BIG_KVRAW), 4096}; pg8::gemm_phase<pg8::EpiBf16<0>, pg8::StaticOrder, true, true>(C.lds + RING_OFF, g, S, E); } PHASE_END
                PHASE_BEGIN phase_kv_build(C, (const bf16*)(BIG + BIG_KVRAW), (const float*)(BIG + BIG_CKV), args.k_norm, rope, (bf16*)(ws + WS_KB), (bf16*)(ws + WS_VB)); PHASE_END
            }
            PHASE_BEGIN { pg8::Gemm g{Hb, (const bf16*)(ws + WS_WDQ) + (size_t)j * DM * QLORA, MTOK, QLORA, DM}; pg8::StaticOrder S; S.init(MTOK, QLORA, C.G, (int)blockIdx.x);
                pg8::EpiF32 E{(float*)(BIG + BIG_CQRAW), QLORA}; pg8::gemm_phase<pg8::EpiF32, pg8::StaticOrder, true, true>(C.lds + RING_OFF, g, S, E); } PHASE_END
            PHASE_BEGIN phase_rms512(C, (const float*)(BIG + BIG_CQRAW), QLORA, args.q_lat_norm + j * QLORA, (bf16*)(BIG + BIG_CQ)); PHASE_END
            PHASE_BEGIN { pg8::Gemm g{(const bf16*)(BIG + BIG_CQ), (const bf16*)(ws + WS_WUQ) + (size_t)j * QLORA * 3072, MTOK, 3072, QLORA}; pg8::StaticOrder S; S.init(MTOK, 3072, C.G, (int)blockIdx.x);
                pg8::EpiBf16<0> E{(bf16*)(BIG + BIG_Q), 3072}; pg8::gemm_phase<pg8::EpiBf16<0>, pg8::StaticOrder, true, true>(C.lds + RING_OFF, g, S, E); } PHASE_END
            PHASE_BEGIN phase_q_post(C, (bf16*)(BIG + BIG_Q), args.q_norm + j * QKD, rope); PHASE_END
            PHASE_BEGIN att::attn_phase(C, (const bf16*)(BIG + BIG_Q), (const bf16*)(ws + WS_KB), (const bf16*)(ws + WS_VB), Hb); PHASE_END
            PHASE_BEGIN { pg8::Gemm g{Hb, (const bf16*)(ws + WS_WO) + (size_t)j * DM * DM, MTOK, DM, DM}; pg8::StaticOrder S; S.init(MTOK, DM, C.G, (int)blockIdx.x);
                pg8::EpiResid E{X, X, DM, modl + 2 * DM, MODW}; pg8::gemm_phase<pg8::EpiResid, pg8::StaticOrder, true, true>(C.lds + RING_OFF, g, S, E); } PHASE_END
        }
        PHASE_BEGIN phase_norm_mod<false>(C, X, args.norm_mlp + layer * DM, modl + 3 * DM, modl + 4 * DM, MODW, Hb, nullptr, nullptr, nullptr, 0, nullptr); PHASE_END
        PHASE_BEGIN { pg8::Gemm g{Hb, (const bf16*)(ws + WS_W1) + (size_t)layer * DM * DFF, MTOK, DFF, DM}; pg8::StaticOrder S; S.init(MTOK, DFF, C.G, (int)blockIdx.x);
            pg8::EpiBf16<1> E{(bf16*)BIG, DFF}; pg8::gemm_phase<pg8::EpiBf16<1>, pg8::StaticOrder, true, true>(C.lds + RING_OFF, g, S, E); } PHASE_END
        PHASE_BEGIN { pg8::Gemm g{(const bf16*)BIG, (const bf16*)(ws + WS_W2) + (size_t)layer * DM * DFF, MTOK, DM, DFF}; pg8::StaticOrder S; S.init(MTOK, DM, C.G, (int)blockIdx.x);
            pg8::EpiResid E{X, X, DM, modl + 5 * DM, MODW}; pg8::gemm_phase<pg8::EpiResid, pg8::StaticOrder, true, true>(C.lds + RING_OFF, g, S, E); } PHASE_END
    }
#undef PHASE_BEGIN
#undef PHASE_END
}

extern "C" void kernel_launch(void* const* d_in, const int* in_sizes, int n_in, void* d_out, int out_size, void* d_ws, size_t ws_size, hipStream_t stream) {
    static int grid = 0;
    if (grid == 0) {
        if (n_in != 25 || in_sizes[0] != MTOK * DM || out_size != MTOK * DM || ws_size < WS_END) {
            fprintf(stderr, "kernel_launch: unexpected shapes / workspace (n_in %d, in0 %d, out %d, ws %zu, need %zu); nothing launched\n", n_in, n_in > 0 ? in_sizes[0] : -1, out_size, ws_size, (size_t)WS_END); grid = -1; return; }
        int dev = 0, cus = 0, per_cu = 0;
        if (hipGetDevice(&dev) != hipSuccess || hipDeviceGetAttribute(&cus, hipDeviceAttributeMultiprocessorCount, dev) != hipSuccess) { grid = -1; return; }
        if (hipFuncSetAttribute((const void*)fwd_kernel, hipFuncAttributeMaxDynamicSharedMemorySize, LDS_BYTES) != hipSuccess) { fprintf(stderr, "kernel_launch: hipFuncSetAttribute failed\n"); grid = -1; return; }
        if (hipOccupancyMaxActiveBlocksPerMultiprocessor(&per_cu, (const void*)fwd_kernel, NWAVES * 64, LDS_BYTES) != hipSuccess || per_cu < 1)
            fprintf(stderr, "kernel_launch: note: occupancy query reports %d workgroups per CU\n", per_cu);
        (void)hipGetLastError();
        grid = cus;
    }
    if (grid < 0) return;
    if (hipMemsetAsync((char*)d_ws + WS_CTL, 0, CTL_ZERO_BYTES, stream) != hipSuccess) return;
    Args a{};
    a.x = (const float*)d_in[0]; a.c = (const float*)d_in[1]; a.positions = (const int*)d_in[2];
    a.ada_w = (const float*)d_in[3]; a.ada_b = (const float*)d_in[4]; a.norm_mix = (const float*)d_in[5]; a.norm_mlp = (const float*)d_in[6];
    a.mlp_w1 = (const float*)d_in[7]; a.mlp_w2 = (const float*)d_in[8]; a.hg_w_in = (const float*)d_in[9]; a.hg_lower = (const float*)d_in[10];
    a.hg_o_norm = (const float*)d_in[11]; a.hg_w_out = (const float*)d_in[12];
    a.kv_ada_w = (const float*)d_in[13]; a.kv_ada_b = (const float*)d_in[14]; a.kv_in_norm = (const float*)d_in[15]; a.w_dkv = (const float*)d_in[16];
    a.kv_norm = (const float*)d_in[17]; a.w_ukv = (const float*)d_in[18]; a.k_norm = (const float*)d_in[19];
    a.w_dq = (const float*)d_in[20]; a.q_lat_norm = (const float*)d_in[21]; a.w_uq = (const float*)d_in[22]; a.q_norm = (const float*)d_in[23]; a.w_o = (const float*)d_in[24];
    a.out = (float*)d_out; a.ws = (unsigned char*)d_ws;
#if MK_MULTI
    for (int p = 0; p < NPHASES; ++p) { a.ph_lo = p; a.ph_hi = p + 1; hipLaunchKernelGGL(fwd_kernel, dim3(grid), dim3(NWAVES * 64), LDS_BYTES, stream, a); }
#else
    a.ph_lo = 0; a.ph_hi = NPHASES;
    hipLaunchKernelGGL(fwd_kernel, dim3(grid), dim3(NWAVES * 64), LDS_BYTES, stream, a);
#endif
    const hipError_t le = hipPeekAtLastError();
    if (le != hipSuccess) fprintf(stderr, "kernel_launch: launch failed: %s\n", hipGetErrorName(le));
}
```

```cpp
#include <hip/hip_runtime.h>
#include <cstdio>
#include <cstdint>

#ifndef PROBE_DUP
#define PROBE_DUP 0
#endif
#ifndef DBG_THIN_XG
#define DBG_THIN_XG 0
#endif
#ifndef DBG_OLD_MIX
#define DBG_OLD_MIX 0
#endif
#ifndef DBG_OLD_MLP
#define DBG_OLD_MLP 0
#endif
#ifndef DBG_OLD_RESID
#define DBG_OLD_RESID 0
#endif
#ifndef DBG_KV_RSTD_IN_BUILD
#define DBG_KV_RSTD_IN_BUILD 0
#endif
#ifndef MK_MULTI
#define MK_MULTI 0
#endif


template <int MASK> __device__ __forceinline__ float xor_f(float v) {
    static_assert(MASK >= 1 && MASK <= 16, "xor_f: in-half masks only; use xor32 for the half exchange");
    return __int_as_float(__builtin_amdgcn_ds_swizzle(__float_as_int(v), (MASK << 10) | 0x1f));
}
__device__ __forceinline__ float xor32(float v, int lane) {
    auto rr = __builtin_amdgcn_permlane32_swap(__float_as_uint(v), __float_as_uint(v), false, false); return lane < 32 ? __uint_as_float(rr[1]) : __uint_as_float(rr[0]);
}
__device__ __forceinline__ float sum32(float v) {
    auto rr = __builtin_amdgcn_permlane32_swap(__float_as_uint(v), __float_as_uint(v), false, false); return __uint_as_float(rr[0]) + __uint_as_float(rr[1]);
}
__device__ __forceinline__ float wave_sum(float v) {
    v += xor_f<1>(v); v += xor_f<2>(v); v += xor_f<4>(v); v += xor_f<8>(v); v += xor_f<16>(v);
    return sum32(v);
}
constexpr float EPS = 1e-6f;

namespace pg8 {
#define PG8_LAS __attribute__((address_space(3)))
typedef unsigned short bf16_t;
typedef short bf16x8 __attribute__((ext_vector_type(8)));
typedef float f32x4 __attribute__((ext_vector_type(4)));
typedef unsigned u32x4 __attribute__((ext_vector_type(4)));
constexpr int BM = 256, BK = 64, HALF = 128, HTB = HALF * BK * 2, STAGE_BYTES = 8 * HTB, NXCD = 8, WGM = 8;

__host__ __device__ __forceinline__ int lds_byte(int r, int c) { const int st = (r >> 4) * 2 + (c >> 5), rr = r & 15, cc = c & 31, ob = rr * 64 + cc * 2; return st * 1024 + (ob ^ (((ob >> 9) & 1) << 5)); }
__host__ __device__ __forceinline__ void stage_rc(int b, int& R, int& C) { const int st = b / 1024, sb = b % 1024, swz = sb ^ (((sb >> 9) & 1) << 5); R = (st >> 1) * 16 + swz / 64; C = (st & 1) * 32 + (swz % 64) / 2; }
__host__ __device__ __forceinline__ int perm32(int rho) { const int n = rho >> 4, i = rho & 15; return 8 * (i >> 2) + 4 * n + (i & 3); }

struct Unit { int pm, pn; };
struct Gemm { const bf16_t* A; const bf16_t* Bt; int M, N, K; };

struct StaticOrder {
    int nM, nN, nwg, G, c;
    __host__ __device__ void init(int M, int N, int G_, int c_) { nM = M / BM; nN = N / BM; nwg = nM * nN; G = G_; c = c_; }
    __host__ __device__ bool next(int i, Unit& u) const {
        const long L = (long)i * G + c; if (L >= nwg) return false;
        int wgid = (int)L; { const int q = nwg / NXCD, r = nwg % NXCD, xcd = wgid % NXCD, off = wgid / NXCD; wgid = (xcd < r ? xcd * (q + 1) : r * (q + 1) + (xcd - r) * q) + off; }
        const int nig = WGM * nN, gid = wgid / nig, fm = gid * WGM, gsz = (nM - fm) < WGM ? (nM - fm) : WGM;
        u.pm = fm + ((wgid % nig) % gsz); u.pn = (wgid % nig) / gsz; return true;
    }
    __device__ __forceinline__ void a_ready(const Unit&) const {}
    __device__ __forceinline__ void done(const Unit&) const {}
};

__device__ __forceinline__ unsigned cvt_pk_bf16(float lo, float hi) { unsigned r; asm volatile("v_cvt_pk_bf16_f32 %0, %1, %2" : "=v"(r) : "v"(lo), "v"(hi)); return r; }

struct RowNorm { const float* ss; const float* sw; int swstride; float inv_n; };
__device__ __forceinline__ void rn_load(const RowNorm& rn, const Unit& u, int row0, int col0, float (&rs)[2][4], f32x4 (&bv)[2][2]) {
#pragma unroll
    for (int ai = 0; ai < 2; ++ai)
#pragma unroll
        for (int m = 0; m < 4; ++m) rs[ai][m] = rn.ss ? rsqrtf(rn.ss[row0 + ai * HALF + m * 16] * rn.inv_n + EPS) : 1.0f;
#pragma unroll
    for (int bj = 0; bj < 2; ++bj)
#pragma unroll
        for (int n = 0; n < 2; ++n) bv[bj][n] = rn.sw ? *(const f32x4*)(rn.sw + (size_t)(u.pm >> 4) * rn.swstride + col0 + bj * HALF + 4 * n) : (f32x4){0.f, 0.f, 0.f, 0.f};
}
template <int ACT  > struct EpiBf16 {
    static constexpr bool PERM = true, AFTER_DRAIN = false;
    bf16_t* O; int ldc; RowNorm rn;
    __device__ __forceinline__ void operator()(const f32x4 (&acc)[2][2][4][2], const Unit& u, int wr, int wc, int fr, int fq) const {
        asm volatile("" : "+v"(fr), "+v"(fq));
        const int row0 = u.pm * BM + wr * 64 + fr; const int col0 = u.pn * BM + wc * 32 + 8 * fq;
        float rs[2][4]; f32x4 bv[2][2]; rn_load(rn, u, row0, col0, rs, bv);
#pragma unroll
        for (int ai = 0; ai < 2; ++ai)
#pragma unroll
            for (int m = 0; m < 4; ++m) { bf16_t* rowp = O + ((unsigned)(row0 + ai * HALF + m * 16) * (unsigned)ldc + (unsigned)col0);
#pragma unroll
                for (int bj = 0; bj < 2; ++bj) { f32x4 v0 = acc[ai][bj][m][0] * rs[ai][m] + bv[bj][0], v1 = acc[ai][bj][m][1] * rs[ai][m] + bv[bj][1];
                    if (ACT == 1) {
#pragma unroll
                        for (int j = 0; j < 4; ++j) { const float a = fmaxf(v0[j], 0.f), b = fmaxf(v1[j], 0.f); v0[j] = a * a; v1[j] = b * b; } }
                    u32x4 w; w.x = cvt_pk_bf16(v0[0], v0[1]); w.y = cvt_pk_bf16(v0[2], v0[3]); w.z = cvt_pk_bf16(v1[0], v1[1]); w.w = cvt_pk_bf16(v1[2], v1[3]);
                    *(u32x4*)(rowp + bj * HALF) = w; } }
    }
};
struct EpiLat {
    static constexpr bool PERM = true, AFTER_DRAIN = false;
    bf16_t* O; int ldo; RowNorm rn; const float* gain; float* ss_out; float* aux; int nlat;
    __device__ __forceinline__ void operator()(const f32x4 (&acc)[2][2][4][2], const Unit& u, int wr, int wc, int fr, int fq) const {
        asm volatile("" : "+v"(fr), "+v"(fq));
        const int row0 = u.pm * BM + wr * 64 + fr; const int col0 = u.pn * BM + wc * 32 + 8 * fq;
        float rs[2][4]; f32x4 bv[2][2]; rn_load(rn, u, row0, col0, rs, bv);
        if (u.pn * BM < nlat) {
            f32x4 gv[2][2];
#pragma unroll
            for (int bj = 0; bj < 2; ++bj)
#pragma unroll
                for (int n = 0; n < 2; ++n) gv[bj][n] = *(const f32x4*)(gain + col0 + bj * HALF + 4 * n);
#pragma unroll
            for (int ai = 0; ai < 2; ++ai)
#pragma unroll
                for (int m = 0; m < 4; ++m) { const int row = row0 + ai * HALF + m * 16; bf16_t* rowp = O + ((unsigned)row * (unsigned)ldo + (unsigned)col0); float part = 0.f;
#pragma unroll
                    for (int bj = 0; bj < 2; ++bj) { const f32x4 v0 = acc[ai][bj][m][0] * rs[ai][m] + bv[bj][0], v1 = acc[ai][bj][m][1] * rs[ai][m] + bv[bj][1];
                        part += (v0[0] * v0[0] + v0[1] * v0[1]) + (v0[2] * v0[2] + v0[3] * v0[3]) + (v1[0] * v1[0] + v1[1] * v1[1]) + (v1[2] * v1[2] + v1[3] * v1[3]);
                        const f32x4 o0 = v0 * gv[bj][0], o1 = v1 * gv[bj][1];
                        u32x4 w; w.x = cvt_pk_bf16(o0[0], o0[1]); w.y = cvt_pk_bf16(o0[2], o0[3]); w.z = cvt_pk_bf16(o1[0], o1[1]); w.w = cvt_pk_bf16(o1[2], o1[3]);
                        *(u32x4*)(rowp + bj * HALF) = w; }
                    part += xor_f<16>(part); part = sum32(part);
                    if (fq == 0) __hip_atomic_fetch_add(ss_out + row, part, __ATOMIC_RELAXED, __HIP_MEMORY_SCOPE_AGENT); }
        } else if (u.pn * BM == nlat && wc < 2) {
#pragma unroll
            for (int ai = 0; ai < 2; ++ai)
#pragma unroll
                for (int m = 0; m < 4; ++m) { const int row = row0 + ai * HALF + m * 16; float* ap = aux + ((unsigned)row * 64u + (unsigned)(wc * 32 + 8 * fq));
                    *(f32x4*)ap = acc[ai][0][m][0] * rs[ai][m] + bv[0][0]; *(f32x4*)(ap + 4) = acc[ai][0][m][1] * rs[ai][m] + bv[0][1]; }
        }
    }
};
struct EpiResid {
    static constexpr bool PERM = false, AFTER_DRAIN = false;
    const float* base; float* out; int ldc; const float* gate; int gstride;
    bf16_t* xg; const float* ngain; const float* nscale; int nstride; float* ss;
    bf16_t* xg2; const float* ngain2; const float* nscale2; int nstride2;
    __device__ __forceinline__ void operator()(const f32x4 (&acc)[2][2][4][2], const Unit& u, int wr, int wc, int fr, int fq) const {
        asm volatile("" : "+v"(fr), "+v"(fq));
        const int row0 = u.pm * BM + wr * 64 + fr, col0 = u.pn * BM + wc * 32 + 4 * fq, b = u.pm >> 4;
        typedef unsigned u32x2 __attribute__((ext_vector_type(2)));
        f32x4 bq[2][4];
#define ER_LOAD(it_) do { const unsigned o_ = (unsigned)(row0 + ((it_) >> 2) * HALF + ((it_) & 3) * 16) * (unsigned)ldc + (unsigned)col0; _Pragma("unroll") for (int q_ = 0; q_ < 4; ++q_) bq[(it_) % 2][q_] = *(const f32x4*)(base + o_ + (q_ >> 1) * HALF + (q_ & 1) * 16); } while (0)
        ER_LOAD(0);
        f32x4 gv[2][2], ns[2][2];
#pragma unroll
        for (int bj = 0; bj < 2; ++bj)
#pragma unroll
            for (int n = 0; n < 2; ++n) { const int c = col0 + bj * HALF + 16 * n;
                gv[bj][n] = *(const f32x4*)(gate + (size_t)b * gstride + c);
                ns[bj][n] = xg ? *(const f32x4*)(ngain + c) * (*(const f32x4*)(nscale + (size_t)b * nstride + c) + 1.0f) : (f32x4){0.f, 0.f, 0.f, 0.f}; }
        float part[8];
#pragma unroll
        for (int it = 0; it < 8; ++it) { const int ai = it >> 2, m = it & 3;
            if (it + 1 < 8) ER_LOAD(it + 1);
            const unsigned off = (unsigned)(row0 + ai * HALF + m * 16) * (unsigned)ldc + (unsigned)col0; float p = 0.f;
#pragma unroll
            for (int bj = 0; bj < 2; ++bj)
#pragma unroll
                for (int n = 0; n < 2; ++n) { const unsigned o = off + bj * HALF + n * 16;
                    const f32x4 x = bq[it % 2][bj * 2 + n] + gv[bj][n] * acc[ai][bj][m][n];
                    *(f32x4*)(out + o) = x;
                    p += (x[0] * x[0] + x[1] * x[1]) + (x[2] * x[2] + x[3] * x[3]);
                    if (xg) { const f32x4 y = x * ns[bj][n]; u32x2 w; w.x = cvt_pk_bf16(y[0], y[1]); w.y = cvt_pk_bf16(y[2], y[3]); *(u32x2*)(xg + o) = w; }
                    if (xg2) { const int c = col0 + bj * HALF + 16 * n;
                        const f32x4 y = x * (*(const f32x4*)(ngain2 + c) * (*(const f32x4*)(nscale2 + (size_t)b * nstride2 + c) + 1.0f));
                        u32x2 w; w.x = cvt_pk_bf16(y[0], y[1]); w.y = cvt_pk_bf16(y[2], y[3]); *(u32x2*)(xg2 + o) = w; } }
            part[it] = p; }
#undef ER_LOAD
        if (ss) {
#pragma unroll
            for (int it = 0; it < 8; ++it) { float p = part[it]; p += xor_f<16>(p); p = sum32(p);
                if (fq == 0) __hip_atomic_fetch_add(ss + (row0 + (it >> 2) * HALF + (it & 3) * 16), p, __ATOMIC_RELAXED, __HIP_MEMORY_SCOPE_AGENT); } }
    }
};
struct EpiF32 {
    static constexpr bool PERM = false, AFTER_DRAIN = false;
    float* C; int ldc; RowNorm rn;
    __device__ __forceinline__ void operator()(const f32x4 (&acc)[2][2][4][2], const Unit& u, int wr, int wc, int fr, int fq) const {
        asm volatile("" : "+v"(fr), "+v"(fq));
        const int row0 = u.pm * BM + wr * 64 + fr, col0 = u.pn * BM + wc * 32 + 4 * fq;
        float rs[2][4];
#pragma unroll
        for (int ai = 0; ai < 2; ++ai)
#pragma unroll
            for (int m = 0; m < 4; ++m) rs[ai][m] = rn.ss ? rsqrtf(rn.ss[row0 + ai * HALF + m * 16] * rn.inv_n + EPS) : 1.0f;
        f32x4 bv[2][2];
#pragma unroll
        for (int bj = 0; bj < 2; ++bj)
#pragma unroll
            for (int n = 0; n < 2; ++n) bv[bj][n] = rn.sw ? *(const f32x4*)(rn.sw + (size_t)(u.pm >> 4) * rn.swstride + col0 + bj * HALF + 16 * n) : (f32x4){0.f, 0.f, 0.f, 0.f};
#pragma unroll
        for (int ai = 0; ai < 2; ++ai)
#pragma unroll
            for (int m = 0; m < 4; ++m) { float* rowp = C + (size_t)(row0 + ai * HALF + m * 16) * ldc + col0;
#pragma unroll
                for (int bj = 0; bj < 2; ++bj)
#pragma unroll
                    for (int n = 0; n < 2; ++n) *(f32x4*)(rowp + bj * HALF + n * 16) = acc[ai][bj][m][n] * rs[ai][m] + bv[bj][n]; }
    }
};
struct EpiResidOld {
    static constexpr bool PERM = false, AFTER_DRAIN = false;
    const float* base; float* out; int ldc; const float* gate; int gstride;
    __device__ __forceinline__ void operator()(const f32x4 (&acc)[2][2][4][2], const Unit& u, int wr, int wc, int fr, int fq) const {
        const int row0 = u.pm * BM + wr * 64 + fr, col0 = u.pn * BM + wc * 32 + 4 * fq;
        const float* gp = gate + (size_t)(u.pm >> 4) * gstride + col0;
        f32x4 gv[2][2];
#pragma unroll
        for (int bj = 0; bj < 2; ++bj)
#pragma unroll
            for (int n = 0; n < 2; ++n) gv[bj][n] = *(const f32x4*)(gp + bj * HALF + n * 16);
#pragma unroll
        for (int ai = 0; ai < 2; ++ai)
#pragma unroll
            for (int m = 0; m < 4; ++m) { const size_t off = (size_t)(row0 + ai * HALF + m * 16) * ldc + col0;
#pragma unroll
                for (int bj = 0; bj < 2; ++bj)
#pragma unroll
                    for (int n = 0; n < 2; ++n) { const f32x4 bs = *(const f32x4*)(base + off + bj * HALF + n * 16);
                        *(f32x4*)(out + off + bj * HALF + n * 16) = bs + gv[bj][n] * acc[ai][bj][m][n]; }
                asm volatile("" ::: "memory"); }
    }
};

template <class Epi, class Sched, bool ALIGN_EPI = false, bool SP2 = false>
__device__ __forceinline__ void gemm_phase(PG8_LAS unsigned char* lds, const Gemm g, const Sched& S, const Epi& E, int tid_in) {
    int tid_ = tid_in; asm volatile("" : "+v"(tid_));
    const int tid = tid_, wid = __builtin_amdgcn_readfirstlane(tid >> 6), lane = tid & 63, wr = wid >> 2, wc = wid & 3, fr = lane & 15, fq = lane >> 4;
    const int K = g.K, nt = K / BK;
    unsigned voffA[2], voffB[2];
#pragma unroll
    for (int i = 0; i < 2; ++i) { int R, C; stage_rc(tid * 16 + i * 8192, R, C); const int Rb = Epi::PERM ? ((R & ~31) + perm32(R & 31)) : R;
        voffA[i] = (unsigned)(R * K + C) * 2u; voffB[i] = (unsigned)(Rb * K + C) * 2u; }
    const size_t kstep = (size_t)(BK * 2);
    const size_t hstep = (size_t)HALF * K * 2;
    const size_t tstep = 2 * hstep;
    const unsigned ldsw = (unsigned)wid * 1024u;
    const int aoff = lds_byte(wr * 64 + fr, fq * 8), boff = lds_byte(wc * 32 + fr, fq * 8);
#define PG8_SA(b, h) (((b) * 2 + (h)) * HTB)
#define PG8_SB(b, h) ((4 + (b) * 2 + (h)) * HTB)
#define PG8_STAGE(bufoff, gbase, voff) do { _Pragma("unroll") for (int _i = 0; _i < 2; ++_i) \
        __builtin_amdgcn_global_load_lds((const unsigned*)((const char*)(gbase) + (voff)[_i]), (PG8_LAS unsigned*)(lds + (bufoff) + ldsw + _i * 8192), 16, 0, 0); } while (0)
#define PG8_LDA(dst, b, h) do { _Pragma("unroll") for (int m = 0; m < 4; ++m) _Pragma("unroll") for (int k = 0; k < 2; ++k) dst[m][k] = *(const PG8_LAS bf16x8*)(lds + PG8_SA(b, h) + aoff + m * 2048 + k * 1024); } while (0)
#define PG8_LDB(dst, b, h) do { _Pragma("unroll") for (int n = 0; n < 2; ++n) _Pragma("unroll") for (int k = 0; k < 2; ++k) dst[n][k] = *(const PG8_LAS bf16x8*)(lds + PG8_SB(b, h) + boff + n * 2048 + k * 1024); } while (0)
#define PG8_MMA(ai, bj, At, Bt) do { __builtin_amdgcn_s_setprio(1); _Pragma("unroll") for (int m = 0; m < 4; ++m) _Pragma("unroll") for (int n = 0; n < 2; ++n) _Pragma("unroll") for (int k = 0; k < 2; ++k) \
        acc[ai][bj][m][n] = __builtin_amdgcn_mfma_f32_16x16x32_bf16(Bt[n][k], At[m][k], acc[ai][bj][m][n], 0, 0, 0); __builtin_amdgcn_s_setprio(0); } while (0)
#define PG8_WAIT_V(n) asm volatile("s_waitcnt vmcnt(" #n ")" ::: "memory")
#define PG8_WAIT_L(n) asm volatile("s_waitcnt lgkmcnt(" #n ")" ::: "memory")
#define PG8_BAR __builtin_amdgcn_s_barrier()
#define PG8_SCHED __builtin_amdgcn_sched_barrier(0)
    Unit cur, nxt; int ui = 0;
    if (!S.next(0, cur)) return;
    f32x4 acc[2][2][4][2];
#pragma unroll
    for (int a = 0; a < 2; ++a)
#pragma unroll
        for (int b = 0; b < 2; ++b)
#pragma unroll
            for (int m = 0; m < 4; ++m)
#pragma unroll
                for (int n = 0; n < 2; ++n) acc[a][b][m][n] = (f32x4){0.f, 0.f, 0.f, 0.f};
    bf16x8 At[4][2], B0[2][2], B1[2][2];
    const char* cA = (const char*)g.A + (size_t)cur.pm * tstep; const char* cB = (const char*)g.Bt + (size_t)cur.pn * tstep;
    S.a_ready(cur);
    if constexpr (SP2) {
        PG8_STAGE(PG8_SB(0, 0), cB, voffB); PG8_STAGE(PG8_SB(0, 1), cB + hstep, voffB); PG8_STAGE(PG8_SA(0, 0), cA, voffA); PG8_STAGE(PG8_SA(0, 1), cA + hstep, voffA);
        if (wr == 1) PG8_BAR;
        PG8_WAIT_V(2); PG8_BAR;
        PG8_STAGE(PG8_SB(1, 0), cB + kstep, voffB); PG8_STAGE(PG8_SA(1, 0), cA + kstep, voffA); PG8_STAGE(PG8_SB(1, 1), cB + hstep + kstep, voffB);
        PG8_WAIT_V(6); PG8_BAR;
    } else {
        PG8_STAGE(PG8_SB(0, 0), cB, voffB); PG8_STAGE(PG8_SA(0, 0), cA, voffA); PG8_STAGE(PG8_SB(0, 1), cB + hstep, voffB); PG8_STAGE(PG8_SA(0, 1), cA + hstep, voffA);
        if (wr == 1) PG8_BAR;
        PG8_WAIT_V(4); PG8_BAR;
        PG8_STAGE(PG8_SB(1, 0), cB + kstep, voffB); PG8_STAGE(PG8_SA(1, 0), cA + kstep, voffA); PG8_STAGE(PG8_SB(1, 1), cB + hstep + kstep, voffB);
        PG8_WAIT_V(6); PG8_BAR;
    }
    for (;;) {
        const bool has_next = S.next(ui + 1, nxt);
        const char* nA = has_next ? (const char*)g.A + (size_t)nxt.pm * tstep : cA; const char* nB = has_next ? (const char*)g.Bt + (size_t)nxt.pn * tstep : cB;
        for (int t = 0; t < nt; t += 2) {
            const bool last = (t == nt - 2);
            const char* a1 = cA + (size_t)(t + 1) * kstep;
            const char* a2 = last ? nA : cA + (size_t)(t + 2) * kstep; const char* b2 = last ? nB : cB + (size_t)(t + 2) * kstep;
            const char* a3 = a2 + kstep; const char* b3 = b2 + kstep;
            if (last && has_next) S.a_ready(nxt);
            if constexpr (SP2) {
            PG8_LDB(B0, 0, 0); PG8_LDB(B1, 0, 1); PG8_SCHED; PG8_LDA(At, 0, 0); PG8_STAGE(PG8_SA(1, 1), a1 + hstep, voffA);
            PG8_WAIT_V(8); PG8_WAIT_L(0); PG8_BAR; PG8_MMA(0, 0, At, B0); PG8_MMA(0, 1, At, B1); PG8_BAR; PG8_SCHED;
            PG8_LDA(At, 0, 1); PG8_STAGE(PG8_SB(0, 0), b2, voffB); PG8_STAGE(PG8_SB(0, 1), b2 + hstep, voffB); PG8_STAGE(PG8_SA(0, 0), a2, voffA);
            PG8_WAIT_V(8); PG8_WAIT_L(0); PG8_BAR; PG8_MMA(1, 0, At, B0); PG8_MMA(1, 1, At, B1); PG8_BAR; PG8_SCHED;
            PG8_LDB(B0, 1, 0); PG8_LDB(B1, 1, 1); PG8_SCHED; PG8_LDA(At, 1, 0); PG8_STAGE(PG8_SA(0, 1), a2 + hstep, voffA);
            PG8_WAIT_V(8); PG8_WAIT_L(0); PG8_BAR; PG8_MMA(0, 0, At, B0); PG8_MMA(0, 1, At, B1); PG8_BAR; PG8_SCHED;
            PG8_LDA(At, 1, 1); PG8_STAGE(PG8_SB(1, 0), b3, voffB); PG8_STAGE(PG8_SB(1, 1), b3 + hstep, voffB); PG8_STAGE(PG8_SA(1, 0), a3, voffA);
            PG8_WAIT_V(8); PG8_WAIT_L(0); PG8_BAR; PG8_MMA(1, 0, At, B0); PG8_MMA(1, 1, At, B1); PG8_BAR; PG8_SCHED;
            } else {
            PG8_LDB(B0, 0, 0); PG8_SCHED; PG8_LDA(At, 0, 0); PG8_STAGE(PG8_SA(1, 1), a1 + hstep, voffA);
            PG8_WAIT_L(8); PG8_BAR; PG8_WAIT_L(0); PG8_MMA(0, 0, At, B0); PG8_BAR; PG8_SCHED;
            PG8_LDB(B1, 0, 1); PG8_STAGE(PG8_SB(0, 0), b2, voffB);
            PG8_BAR; PG8_WAIT_L(0); PG8_MMA(0, 1, At, B1); PG8_BAR;
            PG8_LDA(At, 0, 1); PG8_STAGE(PG8_SA(0, 0), a2, voffA);
            PG8_BAR; PG8_WAIT_L(0); PG8_MMA(1, 0, At, B0); PG8_BAR; PG8_SCHED;
            PG8_STAGE(PG8_SB(0, 1), b2 + hstep, voffB);
            PG8_WAIT_V(6); PG8_BAR; PG8_MMA(1, 1, At, B1); PG8_BAR;
            PG8_LDB(B0, 1, 0); PG8_SCHED; PG8_LDA(At, 1, 0); PG8_STAGE(PG8_SA(0, 1), a2 + hstep, voffA);
            PG8_WAIT_L(8); PG8_BAR; PG8_WAIT_L(0); PG8_MMA(0, 0, At, B0); PG8_BAR; PG8_SCHED;
            PG8_LDB(B1, 1, 1); PG8_STAGE(PG8_SB(1, 0), b3, voffB);
            PG8_BAR; PG8_WAIT_L(0); PG8_MMA(0, 1, At, B1); PG8_BAR;
            PG8_LDA(At, 1, 1); PG8_STAGE(PG8_SA(1, 0), a3, voffA);
            PG8_BAR; PG8_WAIT_L(0); PG8_MMA(1, 0, At, B0); PG8_BAR; PG8_SCHED;
            PG8_STAGE(PG8_SB(1, 1), b3 + hstep, voffB);
            PG8_WAIT_V(6); PG8_BAR; PG8_MMA(1, 1, At, B1); PG8_BAR;
            }
        }
        if constexpr (ALIGN_EPI) { if (wr == 0) PG8_BAR; }
        E(acc, cur, wr, wc, fr, fq); S.done(cur);
#if PROBE_DUP == 9
        if constexpr (Epi::PERM) { asm volatile("" ::: "memory"); E(acc, cur, wr, wc, fr, fq); }
#endif
        if (!has_next) break;
#pragma unroll
        for (int a = 0; a < 2; ++a)
#pragma unroll
            for (int b = 0; b < 2; ++b)
#pragma unroll
                for (int m = 0; m < 4; ++m)
#pragma unroll
                    for (int n = 0; n < 2; ++n) acc[a][b][m][n] = (f32x4){0.f, 0.f, 0.f, 0.f};
        cur = nxt; cA = nA; cB = nB; ++ui;
        if constexpr (ALIGN_EPI) { if (wr == 1) PG8_BAR; }
    }
    PG8_WAIT_V(0);
    if constexpr (!ALIGN_EPI) { if (wr == 0) PG8_BAR; }
    PG8_BAR;
#undef PG8_SA
#undef PG8_SB
#undef PG8_STAGE
#undef PG8_LDA
#undef PG8_LDB
#undef PG8_MMA
#undef PG8_WAIT_V
#undef PG8_WAIT_L
#undef PG8_BAR
#undef PG8_SCHED
}
}

constexpr int NWAVES = 8;
constexpr int DM = 2048, NBATCH = 8, SEQ = 4096, MTOK = NBATCH * SEQ, DEPTH = 4, NA = 2;
constexpr int HG_H = 16, HG_D = 128;
constexpr int MLA_H = 16, NOPE = 128, ROPE = 64, VDIM = 128, QKD = 192, QLORA = 512, KVLORA = 512, CKVN = 768  ;
constexpr int DFF = 8192, NMOD = 6, MODW = NMOD * DM;

constexpr size_t MiB = 1u << 20;
constexpr size_t WS_CTL = 0, CTL_ZERO_BYTES = 3 * MiB;
constexpr size_t WS_SS = 1 * MiB;
constexpr size_t WS_MOD = 3 * MiB;
constexpr size_t WS_KVMOD = WS_MOD + 1536 * 1024;
constexpr size_t WS_SW = 5 * MiB;
constexpr size_t SW_IN = 0, SW_1 = 2 * 8 * 8192 * 4, SW_DQ = SW_1 + 4 * 8 * 8192 * 4, SW_DKV = SW_DQ + 2 * 8 * 512 * 4;
constexpr size_t WS_ROPE = 7 * MiB;
constexpr size_t WS_WIN = 16 * MiB;
constexpr size_t WS_WOUT = 80 * MiB;
constexpr size_t WS_W1 = 96 * MiB;
constexpr size_t WS_W2 = 224 * MiB;
constexpr size_t WS_WDKV = 352 * MiB;
constexpr size_t WS_WUKV = 355 * MiB;
constexpr size_t WS_WDQ = 359 * MiB;
constexpr size_t WS_WUQ = 363 * MiB;
constexpr size_t WS_WO = 369 * MiB;
constexpr size_t WS_H = 385 * MiB;
constexpr size_t WS_BIG = 513 * MiB;
constexpr size_t WS_KB = 1025 * MiB;
constexpr size_t WS_VB = 1217 * MiB;
constexpr size_t WS_XGB = 1345 * MiB;
constexpr size_t WS_END = 1473 * MiB;
constexpr size_t BIG_KVRAW = 128 * MiB, BIG_CKV = 384 * MiB, BIG_CLAT = 480 * MiB;
constexpr size_t BIG_Q = 0, BIG_CQ = 256 * MiB;
constexpr int SS_MIX = 0  , SS_MLP = 4  , SS_CKV = 8, SS_CQ = 9  ;

constexpr int CW_TMO = 0, CW_CODE = 1, CW_BAR = 4096;

constexpr int RING_OFF = 0, RING_BYTES = 131072;
constexpr int LDSCTL_OFF = RING_BYTES, MISC_OFF = LDSCTL_OFF + 320;
constexpr int LDS_BYTES = 147456;

#define GAS __attribute__((address_space(1)))
#define LAS __attribute__((address_space(3)))
typedef unsigned short bf16;
typedef unsigned v4u __attribute__((ext_vector_type(4)));
typedef unsigned v2u __attribute__((ext_vector_type(2)));
typedef float f32x4 __attribute__((ext_vector_type(4)));
typedef float f32x2 __attribute__((ext_vector_type(2)));
typedef float f32x16 __attribute__((ext_vector_type(16)));
typedef short bf16x8 __attribute__((ext_vector_type(8)));
typedef short s16x4 __attribute__((ext_vector_type(4)));
typedef GAS unsigned gu32;
#define RLX_AGENT __ATOMIC_RELAXED, __HIP_MEMORY_SCOPE_AGENT
#define LDS_WAIT() asm volatile("s_waitcnt lgkmcnt(0)" ::: "memory")
#define VM_WAIT() asm volatile("s_waitcnt vmcnt(0)" ::: "memory")
__device__ __forceinline__ unsigned f2bf(float f) { unsigned u = __builtin_bit_cast(unsigned, f); return (u + 0x7fffu + ((u >> 16) & 1u)) >> 16; }
__device__ __forceinline__ unsigned pk2(float lo, float hi) { return f2bf(lo) | (f2bf(hi) << 16); }
__device__ __forceinline__ float bflo(unsigned w) { return __builtin_bit_cast(float, w << 16); }
__device__ __forceinline__ float bfhi(unsigned w) { return __builtin_bit_cast(float, w & 0xffff0000u); }

#define XB_TMO      128
#define XB_XCNT(j)  (256  + 64 * (j))
#define XB_XSUB(j)  (1280 + 64 * (j))
#define XB_XGEN(j)  (2304 + 64 * (j))
#define XB_TOP      3328
#define XB_TOPGEN   3392
#define XCD_BAR_WORDS 3456
#define XB_SPIN_CAP (1u << 22)

__device__ __forceinline__ unsigned xb_ld(unsigned* p)              { return __hip_atomic_load(p, __ATOMIC_RELAXED, __HIP_MEMORY_SCOPE_AGENT); }
__device__ __forceinline__ unsigned xb_add(unsigned* p, unsigned v) { return __hip_atomic_fetch_add(p, v, __ATOMIC_RELAXED, __HIP_MEMORY_SCOPE_AGENT); }
__device__ __forceinline__ unsigned xb_xcc_id() { return (unsigned)__builtin_amdgcn_s_getreg((3 << 11) | 20) & 0xFu; }
#define XB_SPIN(cond, bar) do { unsigned _sp = 0; while (cond) { __builtin_amdgcn_s_sleep(1); \
    if ((++_sp & 255u) == 0u) { if (xb_ld(&(bar)[XB_TMO])) break; if (_sp > XB_SPIN_CAP) { atomicAdd(&(bar)[XB_TMO], 1u); break; } } } } while (0)

struct XcdBarrier { unsigned* bar; unsigned x; volatile LAS unsigned* st; };

__device__ __forceinline__ XcdBarrier xcd_barrier_post(unsigned* bar, volatile LAS unsigned* st) {
    XcdBarrier b; b.bar = bar; b.x = xb_xcc_id(); b.st = st;
    if (threadIdx.x == 0) (void)xb_add(&bar[XB_XCNT(b.x)], 1u);
    return b;
}
__device__ __forceinline__ void xcd_barrier_complete(unsigned* bar, unsigned x, unsigned& nloc, unsigned& nx) {
    const unsigned G = gridDim.x * gridDim.y * gridDim.z;
    unsigned sum, cnt, mine, sp = 0u;
    for (;;) {
        sum = 0u; cnt = 0u; mine = 0u;
#pragma unroll
        for (unsigned j = 0; j < 16; ++j) { const unsigned c = xb_ld(&bar[XB_XCNT(j)]); sum += c; cnt += (c > 0u) ? 1u : 0u; mine = (j == x) ? c : mine; }
        if (sum == G) break;
        __builtin_amdgcn_s_sleep(1);
        if ((++sp & 255u) == 0u) { if (xb_ld(&bar[XB_TMO])) break; if (sp > XB_SPIN_CAP) { atomicAdd(&bar[XB_TMO], 1u); break; } }
    }
    nloc = mine > 0u ? mine : 1u; nx = cnt > 0u ? cnt : 1u;
}
__device__ __forceinline__ void xcd_barrier(const XcdBarrier& b) {
    asm volatile("s_waitcnt vmcnt(0)" ::: "memory");
    __syncthreads();
    if (threadIdx.x == 0) {
        unsigned* bar = b.bar;
        __builtin_amdgcn_s_waitcnt(0);
        unsigned nloc = b.st[0], nx = b.st[1];
        if (nloc == 0u) { xcd_barrier_complete(bar, b.x, nloc, nx); b.st[0] = nloc; b.st[1] = nx; }
        const unsigned old = xb_add(&bar[XB_XSUB(b.x)], 1u);
        const unsigned gen = old / nloc;
        if (old + 1u == (gen + 1u) * nloc) {
            __builtin_amdgcn_fence(__ATOMIC_RELEASE, "agent");
            asm volatile("s_waitcnt vmcnt(0)" ::: "memory");
            const unsigned og = xb_add(&bar[XB_TOP], 1u);
            const unsigned tg = og / nx;
            if (og + 1u == (tg + 1u) * nx) xb_add(&bar[XB_TOPGEN], 1u);
            else XB_SPIN(xb_ld(&bar[XB_TOPGEN]) == tg, bar);
            __builtin_amdgcn_fence(__ATOMIC_ACQUIRE, "agent");
            xb_add(&bar[XB_XGEN(b.x)], 1u);
            asm volatile("s_waitcnt vmcnt(0)" ::: "memory");
        } else {
            XB_SPIN(xb_ld(&bar[XB_XGEN(b.x)]) == gen, bar);
            __builtin_amdgcn_fence(__ATOMIC_ACQUIRE, "agent");
            asm volatile("s_waitcnt vmcnt(0)" ::: "memory");
        }
    }
    __syncthreads();
}

struct Args {
    const float* x; const float* c; const int* positions;
    const float* ada_w; const float* ada_b; const float* norm_mix; const float* norm_mlp;
    const float* mlp_w1; const float* mlp_w2; const float* hg_w_in; const float* hg_lower; const float* hg_o_norm; const float* hg_w_out;
    const float* kv_ada_w; const float* kv_ada_b; const float* kv_in_norm; const float* w_dkv; const float* kv_norm; const float* w_ukv; const float* k_norm;
    const float* w_dq; const float* q_lat_norm; const float* w_uq; const float* q_norm; const float* w_o;
    float* out; unsigned char* ws;
    int ph_lo, ph_hi;
};

struct Ctx { LAS unsigned char* lds; int tid, lane, wave, vcu, G; };
__device__ __forceinline__ Ctx fresh(const Ctx& C0) { Ctx C = C0; int ln; asm volatile("v_mbcnt_lo_u32_b32 %0, -1, 0\n\tv_mbcnt_hi_u32_b32 %0, -1, %0" : "=v"(ln)); int t = C0.wave * 64 + ln;     C.tid = t; C.lane = t & 63; C.wave = __builtin_amdgcn_readfirstlane(t >> 6); return C; }

__device__ __forceinline__ void p0_transpose_item(const float* W, int K, int N, bf16* WT, LAS float* scr, int item, int lane) {
    const int nblk = N / 32, kb = item / nblk, nb = item % nblk, k0 = 64 * kb, n0 = 32 * nb;
#pragma unroll 8
    for (int i = 0; i < 32; ++i) { const int kk = 2 * i + (lane >> 5); scr[kk * 33 + (lane & 31)] = W[(size_t)(k0 + kk) * N + n0 + (lane & 31)]; }
    LDS_WAIT(); asm volatile("" ::: "memory");
    const int c = lane & 7;
#pragma unroll
    for (int j = 0; j < 4; ++j) { const int n = (lane >> 3) + 8 * j; const LAS float* s = scr + (8 * c) * 33 + n;
        v4u o; o.x = pk2(s[0 * 33], s[1 * 33]); o.y = pk2(s[2 * 33], s[3 * 33]); o.z = pk2(s[4 * 33], s[5 * 33]); o.w = pk2(s[6 * 33], s[7 * 33]);
        *(GAS v4u*)(WT + (size_t)(n0 + n) * K + k0 + 8 * c) = o; }
    LDS_WAIT(); asm volatile("" ::: "memory");
}

__device__ __forceinline__ void phase_prologue(const Args& a, const Ctx& C) {
    unsigned char* ws = a.ws;
    {
        LAS float* scr = (LAS float*)(C.lds + RING_OFF + C.wave * 16384);
        const int gw = C.vcu * NWAVES + C.wave, NGW = C.G * NWAVES;
        constexpr int I_IN = (DM / 64) * (4 * DM / 32), I_SQ = (DM / 64) * (DM / 32), I_W1 = (DM / 64) * (DFF / 32), I_W2 = (DFF / 64) * (DM / 32);
        constexpr int I_DKV = (DM / 64) * (576 / 32), I_UKV = (KVLORA / 64) * (4096 / 32), I_DQ = (DM / 64) * (QLORA / 32), I_UQ = (QLORA / 64) * (3072 / 32);
        constexpr int NITEMS = 2 * I_IN + 2 * I_SQ + 4 * I_W1 + 4 * I_W2 + I_DKV + I_UKV + 2 * I_DQ + 2 * I_UQ + 2 * I_SQ;
        for (int it = gw; it < NITEMS; it += NGW) {
            int r = it;
            if (r < 2 * I_IN) { const int l = r / I_IN; p0_transpose_item(a.hg_w_in + (size_t)l * DM * 4 * DM, DM, 4 * DM, (bf16*)(ws + WS_WIN) + (size_t)l * 4 * DM * DM, scr, r % I_IN, C.lane); continue; } r -= 2 * I_IN;
            if (r < 2 * I_SQ) { const int l = r / I_SQ; p0_transpose_item(a.hg_w_out + (size_t)l * DM * DM, DM, DM, (bf16*)(ws + WS_WOUT) + (size_t)l * DM * DM, scr, r % I_SQ, C.lane); continue; } r -= 2 * I_SQ;
            if (r < 4 * I_W1) { const int l = r / I_W1; p0_transpose_item(a.mlp_w1 + (size_t)l * DM * DFF, DM, DFF, (bf16*)(ws + WS_W1) + (size_t)l * DM * DFF, scr, r % I_W1, C.lane); continue; } r -= 4 * I_W1;
            if (r < 4 * I_W2) { const int l = r / I_W2; p0_transpose_item(a.mlp_w2 + (size_t)l * DM * DFF, DFF, DM, (bf16*)(ws + WS_W2) + (size_t)l * DM * DFF, scr, r % I_W2, C.lane); continue; } r -= 4 * I_W2;
            if (r < I_DKV) { p0_transpose_item(a.w_dkv, DM, 576, (bf16*)(ws + WS_WDKV), scr, r, C.lane); continue; } r -= I_DKV;
            if (r < I_UKV) { p0_transpose_item(a.w_ukv, KVLORA, 4096, (bf16*)(ws + WS_WUKV), scr, r, C.lane); continue; } r -= I_UKV;
            if (r < 2 * I_DQ) { const int l = r / I_DQ; p0_transpose_item(a.w_dq + (size_t)l * DM * QLORA, DM, QLORA, (bf16*)(ws + WS_WDQ) + (size_t)l * DM * QLORA, scr, r % I_DQ, C.lane); continue; } r -= 2 * I_DQ;
            if (r < 2 * I_UQ) { const int l = r / I_UQ; p0_transpose_item(a.w_uq + (size_t)l * QLORA * 3072, QLORA, 3072, (bf16*)(ws + WS_WUQ) + (size_t)l * QLORA * 3072, scr, r % I_UQ, C.lane); continue; } r -= 2 * I_UQ;
            { const int l = r / I_SQ; p0_transpose_item(a.w_o + (size_t)l * DM * DM, DM, DM, (bf16*)(ws + WS_WO) + (size_t)l * DM * DM, scr, r % I_SQ, C.lane); }
        }
        { v4u z = {0u, 0u, 0u, 0u}; GAS v4u* p = (GAS v4u*)((bf16*)(ws + WS_WDKV) + (size_t)576 * DM); const int n16 = (768 - 576) * DM * 2 / 16;
          for (int i = C.vcu * 512 + C.tid; i < n16; i += C.G * 512) p[i] = z; }
    }
    {
        GAS f32x2* tab = (GAS f32x2*)(ws + WS_ROPE);
        for (int idx = C.vcu * 512 + C.tid; idx < MTOK * 32; idx += C.G * 512) {
            const int m = idx >> 5, i = idx & 31;
            const float inv = exp2f(-(float)i * 0.41524101186092029f);
            const float ang = (float)a.positions[m] * inv;
            const float n = rintf(ang * 0.15915494309189535f);
            float r = fmaf(-n, 6.2831854820251465f, ang); r = fmaf(-n, -1.7484555e-7f, r);
            tab[idx] = (f32x2){__cosf(r), __sinf(r)};
        }
    }
    __syncthreads();
    {
        LAS float* cs = (LAS float*)(C.lds + RING_OFF);
        LAS float* red = (LAS float*)(C.lds + RING_OFF + 65536);
        for (int i = C.tid; i < NBATCH * DM; i += 512) { const int b = i >> 11, k = i & 2047; const float v = a.c[i]; cs[k * 8 + b] = v / (1.0f + __expf(-v)); }
        __syncthreads();
        constexpr int U_ADA = DEPTH * MODW / 256, U_KV = 2 * DM / 256;
        for (int u = C.vcu; u < U_ADA + U_KV; u += C.G) {
            const float* W; const float* bias; float* outp; int N, n0;
            if (u < U_ADA) { const int l = u / (MODW / 256); n0 = (u % (MODW / 256)) * 256; N = MODW; W = a.ada_w + (size_t)l * DM * MODW; bias = a.ada_b + (size_t)l * MODW; outp = (float*)(ws + WS_MOD) + (size_t)l * NBATCH * MODW; }
            else { n0 = (u - U_ADA) * 256; N = 2 * DM; W = a.kv_ada_w; bias = a.kv_ada_b; outp = (float*)(ws + WS_KVMOD); }
            f32x4 acc[8];
#pragma unroll
            for (int b = 0; b < 8; ++b) acc[b] = (f32x4){0.f, 0.f, 0.f, 0.f};
            const float* wp = W + (size_t)(C.wave * 256) * N + n0 + 4 * C.lane;
#pragma unroll 4
            for (int k = 0; k < 256; ++k) {
                const f32x4 w4 = *(const f32x4*)(wp + (size_t)k * N);
                const f32x4 c0 = *(const LAS f32x4*)(cs + (C.wave * 256 + k) * 8), c1 = *(const LAS f32x4*)(cs + (C.wave * 256 + k) * 8 + 4);
                acc[0] += w4 * c0[0]; acc[1] += w4 * c0[1]; acc[2] += w4 * c0[2]; acc[3] += w4 * c0[3];
                acc[4] += w4 * c1[0]; acc[5] += w4 * c1[1]; acc[6] += w4 * c1[2]; acc[7] += w4 * c1[3];
            }
#pragma unroll
            for (int b = 0; b < 8; ++b) *(LAS f32x4*)(red + (C.wave * 8 + b) * 256 + 4 * C.lane) = acc[b];
            __syncthreads();
            { const int b = C.tid >> 6, cl = 4 * (C.tid & 63); f32x4 s = *(const f32x4*)(bias + n0 + cl);
#pragma unroll
              for (int w = 0; w < 8; ++w) s += *(const LAS f32x4*)(red + (w * 8 + b) * 256 + cl);
              *(f32x4*)(outp + (size_t)b * N + n0 + cl) = s; }
            __syncthreads();
        }
    }
}

__device__ __forceinline__ void phase_prologue_b(const Args& a, const Ctx& C) {
    unsigned char* ws = a.ws;
    LAS float* sh = (LAS float*)(C.lds + RING_OFF);
    const float* mod = (const float*)(ws + WS_MOD); const float* kvmod = (const float*)(ws + WS_KVMOD);
    const int gw = C.vcu * NWAVES + C.wave, NGW = C.G * NWAVES, lane = C.lane;
#pragma unroll 1
    for (int c = 0; c < 9; ++c) {
        const bf16* Wt; int N; const float* shift; int sstride; float* outp; int ostride;
        if (c < 2)      { Wt = (const bf16*)(ws + WS_WIN) + (size_t)c * 4 * DM * DM; N = 4 * DM; shift = mod + (size_t)c * NBATCH * MODW; sstride = MODW; outp = (float*)(ws + WS_SW + SW_IN) + (size_t)c * 8 * 8192; ostride = 8192; }
        else if (c < 6) { const int l = c - 2; Wt = (const bf16*)(ws + WS_W1) + (size_t)l * DM * DFF; N = DFF; shift = mod + (size_t)l * NBATCH * MODW + 3 * DM; sstride = MODW; outp = (float*)(ws + WS_SW + SW_1) + (size_t)l * 8 * 8192; ostride = 8192; }
        else if (c < 8) { const int j = c - 6; Wt = (const bf16*)(ws + WS_WDQ) + (size_t)j * DM * QLORA; N = QLORA; shift = mod + (size_t)(NA + j) * NBATCH * MODW; sstride = MODW; outp = (float*)(ws + WS_SW + SW_DQ) + (size_t)j * 8 * 512; ostride = 512; }
        else            { Wt = (const bf16*)(ws + WS_WDKV); N = CKVN; shift = kvmod; sstride = 2 * DM; outp = (float*)(ws + WS_SW + SW_DKV); ostride = CKVN; }
        for (int i = C.tid; i < NBATCH * DM; i += 512) sh[i] = shift[(size_t)(i >> 11) * sstride + (i & 2047)];
        __syncthreads();
        for (int n = gw; n < N; n += NGW) {
            const bf16* wr = Wt + (size_t)n * DM;
            float acc[8];
#pragma unroll
            for (int b = 0; b < 8; ++b) acc[b] = 0.f;
#pragma unroll
            for (int j = 0; j < 4; ++j) { int k = (j * 64 + lane) * 8; asm volatile("" : "+v"(k));
                const v4u w = *(const GAS v4u*)(wr + k);
                const float w0 = bflo(w.x), w1 = bfhi(w.x), w2 = bflo(w.y), w3 = bfhi(w.y), w4 = bflo(w.z), w5 = bfhi(w.z), w6 = bflo(w.w), w7 = bfhi(w.w);
#pragma unroll
                for (int b = 0; b < 8; ++b) { const f32x4 s0 = *(const LAS f32x4*)(sh + b * DM + k), s1 = *(const LAS f32x4*)(sh + b * DM + k + 4);
                    acc[b] += (w0 * s0[0] + w1 * s0[1]) + (w2 * s0[2] + w3 * s0[3]) + (w4 * s1[0] + w5 * s1[1]) + (w6 * s1[2] + w7 * s1[3]); } }
            float mine = 0.f;
#pragma unroll
            for (int b = 0; b < 8; ++b) { const float t = wave_sum(acc[b]); mine = (lane == b) ? t : mine; }
            if (lane < 8) outp[(size_t)lane * ostride + n] = mine;
        }
        __syncthreads();
    }
    {
        bf16* xga = (bf16*)(ws + WS_H); float* ss = (float*)(ws + WS_SS) + (size_t)SS_MIX * MTOK;
        for (int m = gw; m < MTOK; m += NGW) {
            const int b = m >> 12;
            const f32x4* xr = (const f32x4*)(a.x + (size_t)m * DM) + lane;
            f32x4 v[8]; float s = 0.f;
#pragma unroll
            for (int j = 0; j < 8; ++j) { v[j] = xr[64 * j]; s += (v[j].x * v[j].x + v[j].y * v[j].y) + (v[j].z * v[j].z + v[j].w * v[j].w); }
            s = wave_sum(s); if (lane == 0) ss[m] = s;
#pragma unroll
            for (int j = 0; j < 8; ++j) { const int col = 4 * (lane + 64 * j);
                const f32x4 g = *(const f32x4*)(a.norm_mix + col), sc = *(const f32x4*)(mod + (size_t)b * MODW + DM + col);
                const f32x4 h = v[j] * (g * (sc + 1.0f)); v2u w; w.x = pk2(h.x, h.y); w.y = pk2(h.z, h.w); *(GAS v2u*)(xga + (size_t)m * DM + col) = w; }
        }
    }
}

__device__ __forceinline__ void phase_xg(const Ctx& C, const float* xin, const float* gain, const float* scale, int sstride, bf16* xg, float* ss) {
    const int gw = C.vcu * NWAVES + C.wave, NGW = C.G * NWAVES, lane = C.lane;
    for (int m = gw; m < MTOK; m += NGW) {
        const int b = m >> 12;
        const f32x4* xr = (const f32x4*)(xin + (size_t)m * DM) + lane;
        f32x4 v[8]; float s = 0.f;
#pragma unroll
        for (int j = 0; j < 8; ++j) { v[j] = xr[64 * j]; s += (v[j].x * v[j].x + v[j].y * v[j].y) + (v[j].z * v[j].z + v[j].w * v[j].w); }
        s = wave_sum(s); if (ss && lane == 0) ss[m] = s;
#pragma unroll
        for (int j = 0; j < 8; ++j) { const int col = 4 * (lane + 64 * j);
            const f32x4 g = *(const f32x4*)(gain + col), sc = *(const f32x4*)(scale + (size_t)b * sstride + col);
            const f32x4 h = v[j] * (g * (sc + 1.0f)); v2u w; w.x = pk2(h.x, h.y); w.y = pk2(h.z, h.w); *(GAS v2u*)(xg + (size_t)m * DM + col) = w; }
    }
}

template <bool DUAL>
__device__ __forceinline__ void phase_norm_mod(const Ctx& C, const float* xin, const float* g1, const float* sh1, const float* sc1, int mstride1, bf16* o1,
                                               const float* g2, const float* sh2, const float* sc2, int mstride2, bf16* o2) {
    const int gw = C.vcu * NWAVES + C.wave, NGW = C.G * NWAVES;
    for (int m = gw; m < MTOK; m += NGW) {
        const int b = m >> 12;
        const f32x4* xr = (const f32x4*)(xin + (size_t)m * DM) + C.lane;
        f32x4 v[8]; float s = 0.f;
#pragma unroll
        for (int j = 0; j < 8; ++j) { v[j] = xr[64 * j]; s += (v[j].x * v[j].x + v[j].y * v[j].y) + (v[j].z * v[j].z + v[j].w * v[j].w); }
        const float rstd = 1.0f / sqrtf(wave_sum(s) * (1.0f / DM) + EPS);
#pragma unroll
        for (int j = 0; j < 8; ++j) {
            const int col = 4 * (C.lane + 64 * j);
            const f32x4 y = v[j] * rstd;
            { const f32x4 g = *(const f32x4*)(g1 + col), sh = *(const f32x4*)(sh1 + (size_t)b * mstride1 + col), sc = *(const f32x4*)(sc1 + (size_t)b * mstride1 + col);
              const f32x4 h = (y * g) * (sc + 1.0f) + sh; v2u w; w.x = pk2(h.x, h.y); w.y = pk2(h.z, h.w); *(GAS v2u*)(o1 + (size_t)m * DM + col) = w; }
            if (DUAL) { const f32x4 g = *(const f32x4*)(g2 + col), sh = *(const f32x4*)(sh2 + (size_t)b * mstride2 + col), sc = *(const f32x4*)(sc2 + (size_t)b * mstride2 + col);
              const f32x4 h = (y * g) * (sc + 1.0f) + sh; v2u w; w.x = pk2(h.x, h.y); w.y = pk2(h.z, h.w); *(GAS v2u*)(o2 + (size_t)m * DM + col) = w; }
        }
    }
}
__device__ __forceinline__ void phase_rms512(const Ctx& C, const float* src, int ld, const float* gain, bf16* out) {
    const int gw = C.vcu * NWAVES + C.wave, NGW = C.G * NWAVES;
    const f32x4 g0 = *(const f32x4*)(gain + 4 * C.lane), g1 = *(const f32x4*)(gain + 256 + 4 * C.lane);
    for (int m = gw; m < MTOK; m += NGW) {
        const f32x4* r = (const f32x4*)(src + (size_t)m * ld) + C.lane;
        const f32x4 v0 = r[0], v1 = r[64];
        const float s = (v0.x * v0.x + v0.y * v0.y) + (v0.z * v0.z + v0.w * v0.w) + (v1.x * v1.x + v1.y * v1.y) + (v1.z * v1.z + v1.w * v1.w);
        const float rstd = 1.0f / sqrtf(wave_sum(s) * (1.0f / 512.0f) + EPS);
        const f32x4 a = v0 * rstd * g0, b = v1 * rstd * g1;
        v2u w0, w1; w0.x = pk2(a.x, a.y); w0.y = pk2(a.z, a.w); w1.x = pk2(b.x, b.y); w1.y = pk2(b.z, b.w);
        *(GAS v2u*)(out + (size_t)m * 512 + 4 * C.lane) = w0; *(GAS v2u*)(out + (size_t)m * 512 + 256 + 4 * C.lane) = w1;
    }
}
__device__ __forceinline__ void phase_kv_build(const Ctx& C, const bf16* kvraw, const float* kpe, const float* kgain, const f32x2* rope, bf16* Kb, bf16* Vb, const float* ssdbg = nullptr) {
    const int gw = C.vcu * NWAVES + C.wave, NGW = C.G * NWAVES, lane = C.lane;
    const float kg0 = kgain[2 * lane], kg1 = kgain[2 * lane + 1], kgp = kgain[128 + lane];
    for (int m = gw; m < MTOK; m += NGW) {
        const int b = m >> 12, s = m & 4095;
        const float pe = kpe[(size_t)m * CKVN + 512 + lane];
        const float rdbg = ssdbg ? rsqrtf(ssdbg[m] * (1.0f / 512.0f) + EPS) : 1.0f;
        const float pss = wave_sum(pe * pe);
        const f32x2 cs = rope[(size_t)m * 32 + (lane & 31)];
        const unsigned* kr = (const unsigned*)(kvraw + (size_t)m * 4096);
#pragma unroll 4
        for (int h = 0; h < MLA_H; ++h) {
            const unsigned w = kr[h * 128 + lane], wv = kr[h * 128 + 64 + lane];
            const float k0 = bflo(w) * rdbg, k1 = bfhi(w) * rdbg;
            const float rstd = 1.0f / sqrtf((wave_sum(k0 * k0 + k1 * k1) + pss) * (1.0f / 192.0f) + EPS);
            bf16* ko = Kb + ((size_t)(b * MLA_H + h) * SEQ + s) * QKD;
            *(GAS unsigned*)(ko + 2 * lane) = pk2(k0 * rstd * kg0, k1 * rstd * kg1);
            const float pn = pe * rstd * kgp, other = xor32(pn, lane);
            const float ro = lane < 32 ? pn * cs.x - other * cs.y : pn * cs.x + other * cs.y;
            *(GAS unsigned short*)(ko + 128 + lane) = (unsigned short)f2bf(ro);
            *(GAS unsigned*)(Vb + ((size_t)(b * MLA_H + h) * SEQ + s) * VDIM + 2 * lane) = ssdbg ? pk2(bflo(wv) * rdbg, bfhi(wv) * rdbg) : wv;
        }
    }
}
__device__ __forceinline__ void phase_q_post(const Ctx& C, bf16* Q, const float* qgain, const f32x2* rope) {
    const int gw = C.vcu * NWAVES + C.wave, NGW = C.G * NWAVES, lane = C.lane;
    const float g0 = qgain[2 * lane], g1 = qgain[2 * lane + 1], gp = qgain[128 + lane];
    for (int m = gw; m < MTOK; m += NGW) {
        const f32x2 cs = rope[(size_t)m * 32 + (lane & 31)];
        bf16* qr = Q + (size_t)m * 3072;
#pragma unroll 4
        for (int h = 0; h < MLA_H; ++h) {
            bf16* qh = qr + h * QKD;
            const unsigned w = *(const GAS unsigned*)(qh + 2 * lane); const float pe = bflo((unsigned)*(const GAS unsigned short*)(qh + 128 + lane));
            const float q0 = bflo(w), q1 = bfhi(w);
            const float rstd = 1.0f / sqrtf(wave_sum(q0 * q0 + q1 * q1 + pe * pe) * (1.0f / 192.0f) + EPS);
            *(GAS unsigned*)(qh + 2 * lane) = pk2(q0 * rstd * g0, q1 * rstd * g1);
            const float pn = pe * rstd * gp, other = xor32(pn, lane);
            const float ro = lane < 32 ? pn * cs.x - other * cs.y : pn * cs.x + other * cs.y;
            *(GAS unsigned short*)(qh + 128 + lane) = (unsigned short)f2bf(ro);
        }
    }
}

__device__ __forceinline__ void phase_hgrn_simple(const Ctx& C, const Args& a, int layer, const bf16* proj, bf16* Hout) {
    LAS float* fA = (LAS float*)(C.lds + RING_OFF);
    LAS float* kA = fA + 32 * 128; LAS float* qA = kA + 32 * 128; LAS float* vA = qA + 32 * 128; LAS float* oA = vA + 32 * 128;
    const int tid = C.tid, st = tid >> 4, sc8 = (tid & 15) * 8, j = tid >> 2, qd = tid & 3;
    for (int unit = C.vcu; unit < NBATCH * HG_H; unit += C.G) {
        const int b = unit >> 4, h = unit & 15;
        float lb[8], og[8];
#pragma unroll
        for (int e = 0; e < 8; ++e) { const int c = h * 128 + sc8 + e; const float a0 = a.hg_lower[c], a1 = a.hg_lower[DM + c], a2 = a.hg_lower[2 * DM + c];
            const float mx = fmaxf(a0, fmaxf(a1, a2)), e0 = expf(a0 - mx), e1 = expf(a1 - mx), e2 = expf(a2 - mx), inv = 1.0f / (e0 + e1 + e2);
            lb[e] = (layer == 0) ? e0 * inv : (e0 + e1) * inv; og[e] = a.hg_o_norm[layer * HG_D + sc8 + e]; }
        float S[32];
#pragma unroll
        for (int i = 0; i < 32; ++i) S[i] = 0.f;
        for (int c0 = 0; c0 < SEQ; c0 += 32) {
            const size_t row = (size_t)b * SEQ + c0 + st;
            const bf16* pr = proj + row * (4 * DM) + h * 128 + sc8;
            const v4u q8 = *(const GAS v4u*)pr, z8 = *(const GAS v4u*)(pr + DM), v8 = *(const GAS v4u*)(pr + 2 * DM);
            {
                float qf[8], zf[8], vf[8];
#pragma unroll
                for (int e = 0; e < 4; ++e) { qf[2 * e] = bflo(q8[e]); qf[2 * e + 1] = bfhi(q8[e]); zf[2 * e] = bflo(z8[e]); zf[2 * e + 1] = bfhi(z8[e]); vf[2 * e] = bflo(v8[e]); vf[2 * e + 1] = bfhi(v8[e]); }
                float ff[8], kf[8];
#pragma unroll
                for (int e = 0; e < 8; ++e) { const float sg = 1.0f / (1.0f + __expf(-zf[e])); ff[e] = lb[e] + (1.0f - lb[e]) * sg; kf[e] = (1.0f - lb[e]) * (1.0f - sg); qf[e] *= 0.08838834764831845f; }
                const int o = st * 128 + sc8;
                *(LAS f32x4*)(fA + o) = (f32x4){ff[0], ff[1], ff[2], ff[3]}; *(LAS f32x4*)(fA + o + 4) = (f32x4){ff[4], ff[5], ff[6], ff[7]};
                *(LAS f32x4*)(kA + o) = (f32x4){kf[0], kf[1], kf[2], kf[3]}; *(LAS f32x4*)(kA + o + 4) = (f32x4){kf[4], kf[5], kf[6], kf[7]};
                *(LAS f32x4*)(qA + o) = (f32x4){qf[0], qf[1], qf[2], qf[3]}; *(LAS f32x4*)(qA + o + 4) = (f32x4){qf[4], qf[5], qf[6], qf[7]};
                *(LAS f32x4*)(vA + o) = (f32x4){vf[0], vf[1], vf[2], vf[3]}; *(LAS f32x4*)(vA + o + 4) = (f32x4){vf[4], vf[5], vf[6], vf[7]};
            }
            __syncthreads();
            for (int t = 0; t < 32; ++t) {
                const float vj = vA[t * 128 + j];
                float part = 0.f;
#pragma unroll
                for (int i4 = 0; i4 < 8; ++i4) {
                    const f32x4 f4 = *(const LAS f32x4*)(fA + t * 128 + qd * 32 + i4 * 4), k4 = *(const LAS f32x4*)(kA + t * 128 + qd * 32 + i4 * 4), q4 = *(const LAS f32x4*)(qA + t * 128 + qd * 32 + i4 * 4);
#pragma unroll
                    for (int e = 0; e < 4; ++e) { S[i4 * 4 + e] = fmaf(f4[e], S[i4 * 4 + e], k4[e] * vj); part = fmaf(q4[e], S[i4 * 4 + e], part); }
                }
                part += xor_f<1>(part); part += xor_f<2>(part);
                if (qd == 0) oA[t * 128 + j] = part;
            }
            __syncthreads();
            {
                const f32x4 o0 = *(const LAS f32x4*)(oA + st * 128 + sc8), o1 = *(const LAS f32x4*)(oA + st * 128 + sc8 + 4);
                float ss = (o0.x * o0.x + o0.y * o0.y) + (o0.z * o0.z + o0.w * o0.w) + (o1.x * o1.x + o1.y * o1.y) + (o1.z * o1.z + o1.w * o1.w);
                ss += xor_f<1>(ss); ss += xor_f<2>(ss); ss += xor_f<4>(ss); ss += xor_f<8>(ss);
                const float rstd = 1.0f / sqrtf(ss * (1.0f / 128.0f) + EPS);
                const v4u g8 = *(const GAS v4u*)(pr + 3 * DM);
                const float ov[8] = {o0.x, o0.y, o0.z, o0.w, o1.x, o1.y, o1.z, o1.w};
                float r[8];
#pragma unroll
                for (int e = 0; e < 8; ++e) { const float g = (e & 1) ? bfhi(g8[e >> 1]) : bflo(g8[e >> 1]); const float sl = g / (1.0f + __expf(-g));
                    r[e] = ov[e] * rstd * og[e] * sl; }
                v4u w; w.x = pk2(r[0], r[1]); w.y = pk2(r[2], r[3]); w.z = pk2(r[4], r[5]); w.w = pk2(r[6], r[7]);
                *(GAS v4u*)(Hout + row * DM + h * 128 + sc8) = w;
            }
        }
        __syncthreads();
    }
}

namespace hg {
constexpr int STR = 272, TSTR = 144;
constexpr int OFF_QT = 0, OFF_KT = 17408, OFF_KTT = 34816, OFF_VT = 53248, OFF_ST = 71680, OFF_G = 106496, OFF_TS = 123904, OFF_VEC = 128000, OFF_SS = 129536;
static_assert(OFF_SS + 1024 <= RING_BYTES, "hgrn LDS map");
typedef __bf16 bf16x2_t __attribute__((ext_vector_type(2)));
__device__ __forceinline__ unsigned cvtpk_s(float lo, float hi) { f32x2 v = {lo, hi}; bf16x2_t b = __builtin_convertvector(v, bf16x2_t); return __builtin_bit_cast(unsigned, b); }
template <int SP> __device__ __forceinline__ bf16x8 pack_step(const f32x16& x) {
    v4u p; p.x = cvtpk_s(x[8 * SP], x[8 * SP + 1]); p.y = cvtpk_s(x[8 * SP + 2], x[8 * SP + 3]); p.z = cvtpk_s(x[8 * SP + 4], x[8 * SP + 5]); p.w = cvtpk_s(x[8 * SP + 6], x[8 * SP + 7]);
    return __builtin_bit_cast(bf16x8, p);
}
#define HG_MFMA(a, b, c) __builtin_amdgcn_mfma_f32_32x32x16_bf16((a), (b), (c), 0, 0, 0)
__device__ __forceinline__ void phase_hgrn(const Ctx& C, const Args& a, int layer, const bf16* proj, bf16* Hout) {
    LAS char* L = (LAS char*)C.lds;
    const int tid = C.tid, lane = C.lane, w = C.wave, l32 = lane & 31, hi = lane >> 5;
    const int k0 = 2 * lane, rg = w;
    const int dvb = w & 3, tb = w >> 2, dkb = w >> 1, dvh = w & 1;
    for (int unit = blockIdx.x; unit < NBATCH * HG_H; unit += C.G) {
        const int b = unit >> 4, h = unit & 15;
        float lb0, lb1;
        { const int c = h * 128 + k0;
          { const float a0 = a.hg_lower[c], a1 = a.hg_lower[DM + c], a2 = a.hg_lower[2 * DM + c]; const float mx = fmaxf(a0, fmaxf(a1, a2)), e0 = expf(a0 - mx), e1 = expf(a1 - mx), e2 = expf(a2 - mx), inv = 1.0f / (e0 + e1 + e2); lb0 = (layer == 0) ? e0 * inv : (e0 + e1) * inv; }
          { const float a0 = a.hg_lower[c + 1], a1 = a.hg_lower[DM + c + 1], a2 = a.hg_lower[2 * DM + c + 1]; const float mx = fmaxf(a0, fmaxf(a1, a2)), e0 = expf(a0 - mx), e1 = expf(a1 - mx), e2 = expf(a2 - mx), inv = 1.0f / (e0 + e1 + e2); lb1 = (layer == 0) ? e0 * inv : (e0 + e1) * inv; } }
        if (tid < 128) *(LAS float*)(L + OFF_VEC + 1024 + tid * 4) = a.hg_o_norm[layer * HG_D + tid];
        f32x16 S0, S1;
#pragma unroll
        for (int r = 0; r < 16; ++r) { S0[r] = 0.f; S1[r] = 0.f; }
        unsigned rq[8], rz[8], rv[8], rgt[8];
        const bf16* pbase = proj + ((size_t)b * SEQ + 8 * rg) * (4 * DM) + h * 128 + k0;
#define HG_LOAD(c0_) do { const bf16* p_ = pbase + (size_t)(c0_) * (4 * DM); _Pragma("unroll") for (int r = 0; r < 8; ++r) { \
            rq[r] = *(const GAS unsigned*)(p_ + (size_t)r * (4 * DM)); rz[r] = *(const GAS unsigned*)(p_ + (size_t)r * (4 * DM) + DM); \
            rv[r] = *(const GAS unsigned*)(p_ + (size_t)r * (4 * DM) + 2 * DM); rgt[r] = *(const GAS unsigned*)(p_ + (size_t)r * (4 * DM) + 3 * DM); } } while (0)
        HG_LOAD(0);
        for (int c0 = 0; c0 < SEQ; c0 += 64) {
            float ca[8], cb[8], ka[8], kb[8];
            { float s0 = 0.f, s1 = 0.f;
#pragma unroll
              for (int r = 0; r < 8; ++r) {
                  const float z0 = bflo(rz[r]), z1 = bfhi(rz[r]);
                  const float g0 = 1.0f / (1.0f + __expf(-z0)), g1 = 1.0f / (1.0f + __expf(-z1));
                  const float f0 = lb0 + (1.0f - lb0) * g0, f1 = lb1 + (1.0f - lb1) * g1;
                  s0 += __logf(f0); s1 += __logf(f1); ca[r] = s0; cb[r] = s1;
                  ka[r] = (1.0f - lb0) * (1.0f - g0); kb[r] = (1.0f - lb1) * (1.0f - g1);
                  const float x0 = bflo(rgt[r]), x1 = bfhi(rgt[r]);
                  *(LAS unsigned*)(L + OFF_G + (8 * rg + r) * STR + k0 * 2) = cvtpk_s(x0 / (1.0f + __expf(-x0)), x1 / (1.0f + __expf(-x1)));
              }
              *(LAS f32x2*)(L + OFF_TS + (rg * 128 + k0) * 4) = (f32x2){s0, s1};
              v4u lo, hi4;
              lo.x = (rv[0] & 0xffffu) | (rv[1] << 16); lo.y = (rv[2] & 0xffffu) | (rv[3] << 16); lo.z = (rv[4] & 0xffffu) | (rv[5] << 16); lo.w = (rv[6] & 0xffffu) | (rv[7] << 16);
              hi4.x = (rv[0] >> 16) | (rv[1] & 0xffff0000u); hi4.y = (rv[2] >> 16) | (rv[3] & 0xffff0000u); hi4.z = (rv[4] >> 16) | (rv[5] & 0xffff0000u); hi4.w = (rv[6] >> 16) | (rv[7] & 0xffff0000u);
              *(LAS v4u*)(L + OFF_VT + k0 * TSTR + rg * 16) = lo; *(LAS v4u*)(L + OFF_VT + (k0 + 1) * TSTR + rg * 16) = hi4; }
            __syncthreads();
            { float P0 = 0.f, P1 = 0.f, R0 = 0.f, R1 = 0.f, T0 = 0.f, T1 = 0.f;
#pragma unroll
              for (int g = 0; g < 8; ++g) { const f32x2 t2 = *(const LAS f32x2*)(L + OFF_TS + (g * 128 + k0) * 4);
                  P0 += (g < rg) ? t2.x : 0.f; P1 += (g < rg) ? t2.y : 0.f; if (g < 4) { R0 += t2.x; R1 += t2.y; } T0 += t2.x; T1 += t2.y; }
              unsigned kt[8];
#pragma unroll
              for (int r = 0; r < 8; ++r) {
                  const float b0 = P0 + ca[r] - R0, b1 = P1 + cb[r] - R1;
                  const float q0 = bflo(rq[r]) * 0.08838834764831845f * __expf(b0), q1 = bfhi(rq[r]) * 0.08838834764831845f * __expf(b1);
                  *(LAS unsigned*)(L + OFF_QT + (8 * rg + r) * STR + k0 * 2) = cvtpk_s(q0, q1);
                  kt[r] = cvtpk_s(ka[r] * __expf(-b0), kb[r] * __expf(-b1));
                  *(LAS unsigned*)(L + OFF_KT + (8 * rg + r) * STR + k0 * 2) = kt[r];
              }
              v4u lo, hi4;
              lo.x = (kt[0] & 0xffffu) | (kt[1] << 16); lo.y = (kt[2] & 0xffffu) | (kt[3] << 16); lo.z = (kt[4] & 0xffffu) | (kt[5] << 16); lo.w = (kt[6] & 0xffffu) | (kt[7] << 16);
              hi4.x = (kt[0] >> 16) | (kt[1] & 0xffff0000u); hi4.y = (kt[2] >> 16) | (kt[3] & 0xffff0000u); hi4.z = (kt[4] >> 16) | (kt[5] & 0xffff0000u); hi4.w = (kt[6] >> 16) | (kt[7] & 0xffff0000u);
              *(LAS v4u*)(L + OFF_KTT + k0 * TSTR + rg * 16) = lo; *(LAS v4u*)(L + OFF_KTT + (k0 + 1) * TSTR + rg * 16) = hi4;
              if (rg == 0) { *(LAS f32x2*)(L + OFF_VEC + k0 * 4) = (f32x2){__expf(R0), __expf(R1)}; *(LAS f32x2*)(L + OFF_VEC + 512 + k0 * 4) = (f32x2){__expf(T0 - R0), __expf(T1 - R1)}; } }
            if (c0 + 64 < SEQ) HG_LOAD(c0 + 64);
            __syncthreads();
            bf16x8 qf[8];
            f32x16 D0, D1;
#pragma unroll
            for (int r = 0; r < 16; ++r) { D0[r] = 0.f; D1[r] = 0.f; }
            { const LAS char* qrow = L + OFF_QT + (32 * tb + l32) * STR + hi * 16;
#pragma unroll
              for (int st = 0; st < 8; ++st) qf[st] = *(const LAS bf16x8*)(qrow + st * 32);
              const LAS char* krow = L + OFF_KT + l32 * STR + hi * 16;
#pragma unroll
              for (int st = 0; st < 8; ++st) D0 = HG_MFMA(*(const LAS bf16x8*)(krow + st * 32), qf[st], D0);
              if (tb == 1) {
#pragma unroll
                  for (int st = 0; st < 8; ++st) D1 = HG_MFMA(*(const LAS bf16x8*)(krow + 32 * STR + st * 32), qf[st], D1);
              }
#pragma unroll
              for (int r = 0; r < 16; ++r) { const bool keep = ((r & 3) + 8 * (r >> 2) + 4 * hi) <= l32; if (tb == 0) D0[r] = keep ? D0[r] : 0.f; else D1[r] = keep ? D1[r] : 0.f; } }
#pragma unroll
            for (int g4 = 0; g4 < 4; ++g4) { const f32x4 e4 = *(const LAS f32x4*)(L + OFF_VEC + (32 * dkb + 8 * g4 + 4 * hi) * 4);
#pragma unroll
                for (int j = 0; j < 4; ++j) { S0[4 * g4 + j] *= e4[j]; S1[4 * g4 + j] *= e4[j]; }
                v2u w0, w1; w0.x = cvtpk_s(S0[4 * g4], S0[4 * g4 + 1]); w0.y = cvtpk_s(S0[4 * g4 + 2], S0[4 * g4 + 3]); w1.x = cvtpk_s(S1[4 * g4], S1[4 * g4 + 1]); w1.y = cvtpk_s(S1[4 * g4 + 2], S1[4 * g4 + 3]);
                *(LAS v2u*)(L + OFF_ST + (64 * dvh + l32) * STR + (32 * dkb + 8 * g4 + 4 * hi) * 2) = w0;
                *(LAS v2u*)(L + OFF_ST + (64 * dvh + 32 + l32) * STR + (32 * dkb + 8 * g4 + 4 * hi) * 2) = w1; }
            __syncthreads();
            f32x16 O;
#pragma unroll
            for (int r = 0; r < 16; ++r) O[r] = 0.f;
            { const LAS char* vrow = L + OFF_VT + (32 * dvb + l32) * TSTR + hi * 8;
#define HG_PV(D, sb, sp) do { const s16x4 lo_ = *(const LAS s16x4*)(vrow + (32 * (sb) + 16 * (sp)) * 2), hi_ = *(const LAS s16x4*)(vrow + (32 * (sb) + 16 * (sp) + 8) * 2); \
                O = HG_MFMA(__builtin_shufflevector(lo_, hi_, 0, 1, 2, 3, 4, 5, 6, 7), pack_step<sp>(D), O); } while (0)
              HG_PV(D0, 0, 0); HG_PV(D0, 0, 1);
              if (tb == 1) { HG_PV(D1, 1, 0); HG_PV(D1, 1, 1); }
#undef HG_PV
              const LAS char* srow = L + OFF_ST + (32 * dvb + l32) * STR + hi * 16;
#pragma unroll
              for (int kk = 0; kk < 8; ++kk) O = HG_MFMA(*(const LAS bf16x8*)(srow + kk * 32), qf[kk], O); }
            { const LAS char* arow = L + OFF_KTT + (32 * dkb + l32) * TSTR + hi * 16;
              const LAS char* b0row = L + OFF_VT + (64 * dvh + l32) * TSTR + hi * 16;
#pragma unroll
              for (int st = 0; st < 4; ++st) { const bf16x8 A = *(const LAS bf16x8*)(arow + st * 32);
                  S0 = HG_MFMA(A, *(const LAS bf16x8*)(b0row + st * 32), S0); S1 = HG_MFMA(A, *(const LAS bf16x8*)(b0row + 32 * TSTR + st * 32), S1); }
#pragma unroll
              for (int g4 = 0; g4 < 4; ++g4) { const f32x4 e4 = *(const LAS f32x4*)(L + OFF_VEC + 512 + (32 * dkb + 8 * g4 + 4 * hi) * 4);
#pragma unroll
                  for (int j = 0; j < 4; ++j) { S0[4 * g4 + j] *= e4[j]; S1[4 * g4 + j] *= e4[j]; } } }
            { float ss = 0.f;
#pragma unroll
              for (int r = 0; r < 16; ++r) ss = fmaf(O[r], O[r], ss);
              ss += xor32(ss, lane);
              if (hi == 0) *(LAS float*)(L + OFF_SS + (dvb * 64 + 32 * tb + l32) * 4) = ss; }
            __syncthreads();
            { const int t = 32 * tb + l32;
              const float tot = *(const LAS float*)(L + OFF_SS + t * 4) + *(const LAS float*)(L + OFF_SS + (64 + t) * 4) + *(const LAS float*)(L + OFF_SS + (128 + t) * 4) + *(const LAS float*)(L + OFF_SS + (192 + t) * 4);
              const float rstd = 1.0f / sqrtf(tot * (1.0f / 128.0f) + EPS);
#pragma unroll
              for (int g4 = 0; g4 < 4; ++g4) { const int dv = 32 * dvb + 8 * g4 + 4 * hi;
                  const f32x4 og4 = *(const LAS f32x4*)(L + OFF_VEC + 1024 + dv * 4); const v2u gw = *(const LAS v2u*)(L + OFF_G + t * STR + dv * 2);
                  v2u o2; o2.x = cvtpk_s(O[4 * g4] * rstd * og4[0] * bflo(gw.x), O[4 * g4 + 1] * rstd * og4[1] * bfhi(gw.x));
                  o2.y = cvtpk_s(O[4 * g4 + 2] * rstd * og4[2] * bflo(gw.y), O[4 * g4 + 3] * rstd * og4[3] * bfhi(gw.y));
                  *(LAS v2u*)(L + OFF_KT + t * STR + dv * 2) = o2; } }
            __syncthreads();
            { const int row = tid >> 4, c8 = (tid & 15) * 8;
              bf16* op = Hout + ((size_t)b * SEQ + c0 + row) * DM + h * 128 + c8;
              *(GAS v4u*)op = *(const LAS v4u*)(L + OFF_KT + row * STR + c8 * 2);
              *(GAS v4u*)(op + (size_t)32 * DM) = *(const LAS v4u*)(L + OFF_KT + (row + 32) * STR + c8 * 2); }
        }
        __syncthreads();
#undef HG_LOAD
    }
}
#undef HG_MFMA
}

namespace att {
constexpr int KROW = 400;
constexpr int SHM_K = 64 * KROW;
constexpr int SHM_V = 64 * 128 * 2;
constexpr int V_OFF = 0, K_OFF = 2 * SHM_V, WS_OFF = K_OFF + 2 * SHM_K;
constexpr float SCALE = 0.07216878364870322f;
constexpr float THR = 8.f;
#define SBAR() __builtin_amdgcn_sched_barrier(0)
__device__ __forceinline__ int v_st(int k, int c) { const int kk = (k & ~0xC) | ((k & 4) << 1) | ((k & 8) >> 1); return ((kk >> 3) * 4 + (c >> 5)) * 512 + ((kk & 7) * 32 + (c & 31)) * 2; }
__device__ __forceinline__ int v_rd_base(int lane) { return ((lane & 3) << 3) | (((lane >> 2) & 3) << 6) | (((lane >> 4) & 1) << 5) | (((lane >> 5) & 1) << 8); }
constexpr int v_rd_off(int d0, int ks, int half) { return d0 * 512 + ks * 4096 + half * 2048; }
__device__ __forceinline__ int crow(int r, int hi) { return (r & 3) + 8 * (r >> 2) + 4 * hi; }
__device__ __forceinline__ unsigned cvtpk(float lo, float hi) { unsigned r; asm volatile("v_cvt_pk_bf16_f32 %0, %1, %2" : "=v"(r) : "v"(lo), "v"(hi)); return r; }

__device__ __forceinline__ void mask_tile(f32x16& p0, f32x16& p1, int dq) {
    const float NEG = -__builtin_inff();
#pragma unroll
    for (int r = 0; r < 16; ++r) {
        const int c = (r & 3) + 8 * (r >> 2);
        if (dq - c < 0) p0[r] = NEG;
        if (dq - c - 32 < 0) p1[r] = NEG;
    }
}
__device__ __forceinline__ void partialSM(f32x16& p0, f32x16& p1, float& m_reg, float& mn, float& alpha) {
    float pmax = p0[0];
#pragma unroll
    for (int r = 1; r < 16; ++r) pmax = fmaxf(pmax, p0[r]);
#pragma unroll
    for (int r = 0; r < 16; ++r) pmax = fmaxf(pmax, p1[r]);
    { auto rr = __builtin_amdgcn_permlane32_swap(__float_as_uint(pmax), __float_as_uint(pmax), false, false);
      pmax = fmaxf(__uint_as_float(rr[0]), __uint_as_float(rr[1])); }
    constexpr float C2 = 1.4426950408889634f * SCALE;
    if (__builtin_expect(__all((pmax - m_reg) * SCALE <= THR), 1)) { mn = m_reg; alpha = 1.f; }
    else { mn = fmaxf(m_reg, pmax); alpha = __builtin_amdgcn_exp2f((m_reg - mn) * C2); m_reg = mn; }
    const float mnL = -mn * C2;
#pragma unroll
    for (int r = 0; r < 16; ++r) p0[r] = fmaf(p0[r], C2, mnL);
#pragma unroll
    for (int r = 0; r < 16; ++r) p1[r] = fmaf(p1[r], C2, mnL);
#pragma unroll
    for (int r = 0; r < 16; ++r) p0[r] = __builtin_amdgcn_exp2f(p0[r]);
}
__device__ __forceinline__ void finishSM(f32x16& p0, f32x16& p1, float alpha, float& l_reg, bf16x8& pa0, bf16x8& pa1, bf16x8& pa2, bf16x8& pa3) {
#pragma unroll
    for (int r = 0; r < 16; ++r) p1[r] = __builtin_amdgcn_exp2f(p1[r]);
    float ps = 0;
#pragma unroll
    for (int r = 0; r < 16; ++r) ps += p0[r];
#pragma unroll
    for (int r = 0; r < 16; ++r) ps += p1[r];
    { auto rr = __builtin_amdgcn_permlane32_swap(__float_as_uint(ps), __float_as_uint(ps), false, false);
      ps = __uint_as_float(rr[0]) + __uint_as_float(rr[1]); }
    l_reg = l_reg * alpha + ps;
#define PK4(P, B_, OUT) do { unsigned a0 = cvtpk(P[B_+0], P[B_+1]), a1 = cvtpk(P[B_+2], P[B_+3]);                          \
        unsigned b0 = cvtpk(P[B_+4], P[B_+5]), b1 = cvtpk(P[B_+6], P[B_+7]);                                             \
        auto r0 = __builtin_amdgcn_permlane32_swap(a0, b0, false, false); auto r1 = __builtin_amdgcn_permlane32_swap(a1, b1, false, false); \
        v4u w = {r0[0], r1[0], r0[1], r1[1]}; OUT = __builtin_bit_cast(bf16x8, w); } while (0)
    PK4(p0, 0, pa0); PK4(p0, 8, pa1); PK4(p1, 0, pa2); PK4(p1, 8, pa3);
#undef PK4
}
template <int KB>
__device__ __forceinline__ void qkt(f32x16& p0, f32x16& p1, const LAS char* lds, int kbase, const bf16x8* qr) {
#pragma unroll
    for (int r = 0; r < 16; ++r) { p0[r] = 0.f; p1[r] = 0.f; }
    const LAS char* a = lds + K_OFF + KB * SHM_K + kbase;
#pragma unroll
    for (int d0 = 0; d0 < 12; ++d0) {
        const bf16x8 b0 = *(const LAS bf16x8*)(a + d0 * 32);
        const bf16x8 b1 = *(const LAS bf16x8*)(a + d0 * 32 + 32 * KROW);
        p0 = __builtin_amdgcn_mfma_f32_32x32x16_bf16(b0, qr[d0], p0, 0, 0, 0);
        p1 = __builtin_amdgcn_mfma_f32_32x32x16_bf16(b1, qr[d0], p1, 0, 0, 0); }
}
template <int VB>
__device__ __forceinline__ void pv_tile(f32x16* o, int vb0, bf16x8 pa0, bf16x8 pa1, bf16x8 pa2, bf16x8 pa3) {
#define TRRD(dst, off) asm volatile("ds_read_b64_tr_b16 %0, %1 offset:%2" : "=&v"(dst) : "v"(vb0), "i"(off) : "memory")
#define PV_D0(d0) do { s16x4 l0, l1, l2, l3, h0, h1, h2, h3; constexpr int b_ = V_OFF + VB * SHM_V + v_rd_off(d0, 0, 0); \
        TRRD(l0, b_); TRRD(h0, b_ + 2048); TRRD(l1, b_ + 4096); TRRD(h1, b_ + 6144); TRRD(l2, b_ + 8192); TRRD(h2, b_ + 10240); TRRD(l3, b_ + 12288); TRRD(h3, b_ + 14336); \
        asm volatile("s_waitcnt lgkmcnt(0)" ::: "memory"); SBAR();   \
        o[d0] = __builtin_amdgcn_mfma_f32_32x32x16_bf16(pa0, (bf16x8){l0[0], l0[1], l0[2], l0[3], h0[0], h0[1], h0[2], h0[3]}, o[d0], 0, 0, 0);   \
        o[d0] = __builtin_amdgcn_mfma_f32_32x32x16_bf16(pa1, (bf16x8){l1[0], l1[1], l1[2], l1[3], h1[0], h1[1], h1[2], h1[3]}, o[d0], 0, 0, 0);   \
        o[d0] = __builtin_amdgcn_mfma_f32_32x32x16_bf16(pa2, (bf16x8){l2[0], l2[1], l2[2], l2[3], h2[0], h2[1], h2[2], h2[3]}, o[d0], 0, 0, 0);   \
        o[d0] = __builtin_amdgcn_mfma_f32_32x32x16_bf16(pa3, (bf16x8){l3[0], l3[1], l3[2], l3[3], h3[0], h3[1], h3[2], h3[3]}, o[d0], 0, 0, 0); } while (0)
    PV_D0(0); PV_D0(1); PV_D0(2); PV_D0(3);
#undef PV_D0
#undef TRRD
}

__device__ __forceinline__ void attn_block(const Ctx& C, int b, int h, int qb, const bf16* Q, const bf16* Kb, const bf16* Vb, bf16* O) {
    const int tid = C.tid, wid = C.wave, lane = C.lane, r32 = lane & 31, hi = lane >> 5;
    const LAS char* lds = (const LAS char*)C.lds;
    LAS char* ldsw = (LAS char*)C.lds;
    const int P0 = qb * 256, qlo = P0 + wid * 32, NT = (P0 + 256) / 64;
    const bf16* Kh = Kb + (size_t)(b * MLA_H + h) * SEQ * QKD;
    const bf16* Vh = Vb + (size_t)(b * MLA_H + h) * SEQ * VDIM;
    bf16x8 qr[12];
    { const bf16* qp = Q + (size_t)(b * SEQ + qlo + r32) * 3072 + h * QKD + hi * 8;
#pragma unroll
      for (int d0 = 0; d0 < 12; ++d0) qr[d0] = *(const GAS bf16x8*)(qp + d0 * 16); }
    LAS float* wsf = (LAS float*)(ldsw + WS_OFF) + wid * 64; LAS float* li_l = wsf; LAS float* al_l = wsf + 32;
    float m_reg = -1e30f, l_reg = 0.f; f32x16 o[4];
#pragma unroll
    for (int d = 0; d < 4; ++d)
#pragma unroll
        for (int r = 0; r < 16; ++r) o[d][r] = 0.f;
    int kdst[3];
#pragma unroll
    for (int i = 0; i < 3; ++i) { const int c = tid + 512 * i; kdst[i] = (c / 24) * KROW + (c % 24) * 16; }
    const int sr = tid >> 4, sc = (tid & 15) * 8, vst0 = v_st(sr, sc), vst1 = v_st(32 + sr, sc);
    const int kbase = r32 * KROW + hi * 16;
    const int vb0 = (int)(unsigned)(uintptr_t)(ldsw) + v_rd_base(lane);
    const int qm = qlo + r32 - 4 * hi;
    bf16x8 sk0, sk1, sk2, sv0, sv1;
#define A_LOAD(t) do { const bf16* kp = Kh + (size_t)(t) * 64 * QKD + tid * 8; sk0 = *(const GAS bf16x8*)kp; sk1 = *(const GAS bf16x8*)(kp + 4096); sk2 = *(const GAS bf16x8*)(kp + 8192); \
        const bf16* vp = Vh + (size_t)((t) * 64 + sr) * VDIM + sc; sv0 = *(const GAS bf16x8*)vp; sv1 = *(const GAS bf16x8*)(vp + 32 * VDIM); } while (0)
#define A_WRITE(bf) do { *(LAS bf16x8*)(ldsw + K_OFF + (bf) * SHM_K + kdst[0]) = sk0; *(LAS bf16x8*)(ldsw + K_OFF + (bf) * SHM_K + kdst[1]) = sk1; *(LAS bf16x8*)(ldsw + K_OFF + (bf) * SHM_K + kdst[2]) = sk2; \
        *(LAS bf16x8*)(ldsw + V_OFF + (bf) * SHM_V + vst0) = sv0; *(LAS bf16x8*)(ldsw + V_OFF + (bf) * SHM_V + vst1) = sv1; } while (0)
#define RESC(aa) do { if (__any((aa) < 1.f)) { if (hi == 0) al_l[r32] = (aa); asm volatile("s_waitcnt lgkmcnt(0)" ::: "memory");              \
        _Pragma("unroll") for (int d_ = 0; d_ < 4; ++d_) _Pragma("unroll") for (int r = 0; r < 16; ++r) o[d_][r] *= al_l[crow(r, hi)]; } } while (0)
#define A_COMPUTE(t, BF) do { const int kb_ = (t) * 64; if (kb_ <= qlo + 31) { f32x16 p0, p1; float mn, al; bf16x8 pa0, pa1, pa2, pa3;   \
        qkt<BF>(p0, p1, lds, kbase, qr);                                              \
        if (kb_ + 63 > qlo) mask_tile(p0, p1, qm - kb_);                               \
        partialSM(p0, p1, m_reg, mn, al); finishSM(p0, p1, al, l_reg, pa0, pa1, pa2, pa3); RESC(al); SBAR();  \
        pv_tile<BF>(o, vb0, pa0, pa1, pa2, pa3); } } while (0)
    A_LOAD(0); VM_WAIT(); A_WRITE(0); __syncthreads();
    for (int t = 0; t < NT; t += 2) {
        A_LOAD(t + 1);
        A_COMPUTE(t, 0);
        VM_WAIT(); A_WRITE(1); __syncthreads();
        if (t + 2 < NT) A_LOAD(t + 2);
        A_COMPUTE(t + 1, 1);
        if (t + 2 < NT) { VM_WAIT(); A_WRITE(0); }
        __syncthreads();
    }
    if (hi == 0) li_l[r32] = l_reg;
    asm volatile("s_waitcnt lgkmcnt(0)" ::: "memory");
    int hi_e = hi, r32_e = r32; asm volatile("" : "+v"(hi_e), "+v"(r32_e));
    bf16* Ow = O + (size_t)(b * SEQ + qlo + 4 * hi_e) * DM + h * VDIM + r32_e;
#pragma unroll
    for (int r = 0; r < 16; ++r) { const int orow = (r & 3) + 8 * (r >> 2); const float rl = __builtin_amdgcn_rcpf(li_l[orow + 4 * hi_e]);
#pragma unroll
        for (int d0 = 0; d0 < 4; ++d0) { const float v = o[d0][r] * rl; const float vn = xor_f<1>(v);
            if ((r32_e & 1) == 0) *(GAS unsigned*)(Ow + (size_t)orow * DM + d0 * 32) = cvtpk(v, vn); } }
    __syncthreads();
#undef A_LOAD
#undef A_WRITE
#undef RESC
#undef A_COMPUTE
}
__device__ __forceinline__ void attn_phase(const Ctx& C, const bf16* Q, const bf16* Kb, const bf16* Vb, bf16* O) {
    constexpr int NITEM = NBATCH * MLA_H * 8;
    for (int L = C.vcu; L < NITEM; L += C.G) {
        const int bh = L >> 3, x = L & 7;
        attn_block(C, bh >> 4, bh & 15, 15 - x, Q, Kb, Vb, O);
        attn_block(C, bh >> 4, bh & 15, x, Q, Kb, Vb, O);
    }
}
}

constexpr int NPHASES = (DBG_THIN_XG ? 30 + 3 + 1 + 4 : 30) + (DBG_OLD_MIX ? 4 : 0) + (DBG_OLD_MLP ? 4 : 0);
__global__ void __launch_bounds__(NWAVES * 64, 2) fwd_kernel(Args args) {
    extern __shared__ __attribute__((aligned(16))) unsigned char lds_raw[];
    Ctx C0;
    C0.lds = (LAS unsigned char*)lds_raw;
    C0.tid = threadIdx.x; C0.lane = C0.tid & 63; C0.wave = __builtin_amdgcn_readfirstlane(C0.tid >> 6);
    C0.G = gridDim.x; { const int bx = blockIdx.x; C0.vcu = (C0.G % 8 == 0) ? (bx % 8) * (C0.G / 8) + bx / 8 : bx; }
    volatile LAS unsigned* MISC = (volatile LAS unsigned*)(C0.lds + MISC_OFF);
    unsigned char* ws = args.ws;
    gu32* ctl = (gu32*)(ws + WS_CTL);
    for (int u = C0.tid; u < (LDS_BYTES - LDSCTL_OFF) / 4; u += NWAVES * 64) ((LAS unsigned*)(C0.lds + LDSCTL_OFF))[u] = 0u;
    __syncthreads();
#if MK_MULTI
#define GRID_BAR() do { } while (0)
#else
    XcdBarrier bar = xcd_barrier_post((unsigned*)(ctl + CW_BAR), MISC + 8);
#define GRID_BAR() do { XcdBarrier b2_ = bar; asm volatile("" : "+s"(b2_.bar), "+s"(b2_.x)); xcd_barrier(b2_); } while (0)
#endif
    const int lo = args.ph_lo, hi = args.ph_hi;
    int ph = 0;
#define PHASE_BEGIN if (ph >= lo && ph < hi) { const Ctx C = fresh(C0);
#define PHASE_END   if (ph + 1 < hi) GRID_BAR(); } ++ph;
#define REP_BEGIN(cls) { int nrep_ = (PROBE_DUP == (cls)) ? 2 : 1; asm volatile("" : "+s"(nrep_)); _Pragma("unroll 1") for (int rep_ = 0; rep_ < nrep_; ++rep_) { const Ctx C = fresh(C0);
#define REP_END __syncthreads(); } }

    float* const X = args.out;
    bf16* const Hb = (bf16*)(ws + WS_H);
    bf16* const XGB = (bf16*)(ws + WS_XGB);
    bf16* const HKV = (bf16*)(ws + WS_KB);
    unsigned char* const BIG = ws + WS_BIG;
    const float* const mod = (const float*)(ws + WS_MOD);
    const float* const kvmod = (const float*)(ws + WS_KVMOD);
    const f32x2* const rope = (const f32x2*)(ws + WS_ROPE);
    float* const SS = (float*)(ws + WS_SS);
    constexpr float INV_D = 1.0f / DM, INV_LAT = 1.0f / 512.0f;
    const pg8::RowNorm RN_NONE{nullptr, nullptr, 0, 0.f};

    PHASE_BEGIN REP_BEGIN(4) phase_prologue(args, C); REP_END PHASE_END
    PHASE_BEGIN REP_BEGIN(10) phase_prologue_b(args, C); REP_END PHASE_END

#pragma unroll 1
    for (int layer = 0; layer < DEPTH; ++layer) {
        const float* modl = mod + (size_t)layer * NBATCH * MODW;
        const float* xin = (layer == 0) ? args.x : X;
#if DBG_OLD_MIX
        PHASE_BEGIN
        if (layer == NA) phase_norm_mod<true>(C, xin, args.norm_mix + layer * DM, modl, modl + DM, MODW, Hb, args.kv_in_norm, kvmod, kvmod + DM, 2 * DM, HKV);
        else phase_norm_mod<false>(C, xin, args.norm_mix + layer * DM, modl, modl + DM, MODW, Hb, nullptr, nullptr, nullptr, 0, nullptr);
        PHASE_END
#endif
#if DBG_THIN_XG
        if (layer > 0) { PHASE_BEGIN phase_xg(C, X, args.norm_mix + layer * DM, modl + DM, MODW, Hb, SS + (size_t)(SS_MIX + layer) * MTOK); PHASE_END
            if (layer == NA) { PHASE_BEGIN phase_xg(C, X, args.kv_in_norm, kvmod + DM, 2 * DM, HKV, nullptr); PHASE_END } }
#endif
        if (layer < NA) {
            PHASE_BEGIN { pg8::Gemm g{Hb, (const bf16*)(ws + WS_WIN) + (size_t)layer * 4 * DM * DM, MTOK, 4 * DM, DM}; pg8::StaticOrder S; S.init(MTOK, 4 * DM, C.G, (int)blockIdx.x);
                pg8::EpiBf16<0> E{(bf16*)BIG, 4 * DM, DBG_OLD_MIX ? RN_NONE : pg8::RowNorm{SS + (size_t)(SS_MIX + layer) * MTOK, (const float*)(ws + WS_SW + SW_IN) + (size_t)layer * 8 * 8192, 8192, INV_D}};
                pg8::gemm_phase<pg8::EpiBf16<0>, pg8::StaticOrder, true, true>(C.lds + RING_OFF, g, S, E, C.tid); } PHASE_END
            PHASE_BEGIN REP_BEGIN(2) hg::phase_hgrn(C, args, layer, (const bf16*)BIG, Hb); REP_END PHASE_END
            PHASE_BEGIN { pg8::Gemm g{Hb, (const bf16*)(ws + WS_WOUT) + (size_t)layer * DM * DM, MTOK, DM, DM}; pg8::StaticOrder S; S.init(MTOK, DM, C.G, (int)blockIdx.x);
                #if DBG_OLD_RESID
                pg8::EpiResidOld E{xin, X, DM, modl + 2 * DM, MODW}; pg8::gemm_phase<pg8::EpiResidOld, pg8::StaticOrder, true, true>(C.lds + RING_OFF, g, S, E, C.tid);
#else
                pg8::EpiResid E{xin, X, DM, modl + 2 * DM, MODW, (DBG_THIN_XG || DBG_OLD_MLP) ? nullptr : XGB, args.norm_mlp + layer * DM, modl + 4 * DM, MODW, (DBG_THIN_XG || DBG_OLD_MLP) ? nullptr : SS + (size_t)(SS_MLP + layer) * MTOK, nullptr, nullptr, nullptr, 0};
                pg8::gemm_phase<pg8::EpiResid, pg8::StaticOrder, true, true>(C.lds + RING_OFF, g, S, E, C.tid);
#endif
 } PHASE_END
        } else {
            const int j = layer - NA;
            if (layer == NA) {
                PHASE_BEGIN { pg8::Gemm g{HKV, (const bf16*)(ws + WS_WDKV), MTOK, CKVN, DM}; pg8::StaticOrder S; S.init(MTOK, CKVN, C.G, (int)blockIdx.x);
                    pg8::EpiF32 E{(float*)(BIG + BIG_CKV), CKVN, DBG_OLD_MIX ? RN_NONE : pg8::RowNorm{SS + (size_t)(SS_MIX + NA) * MTOK, (const float*)(ws + WS_SW + SW_DKV), CKVN, INV_D}};
                    pg8::gemm_phase<pg8::EpiF32, pg8::StaticOrder, true, true>(C.lds + RING_OFF, g, S, E, C.tid); } PHASE_END
                PHASE_BEGIN phase_rms512(C, (const float*)(BIG + BIG_CKV), CKVN, args.kv_norm, (bf16*)(BIG + BIG_CLAT)); PHASE_END
                PHASE_BEGIN { pg8::Gemm g{(const bf16*)(BIG + BIG_CLAT), (const bf16*)(ws + WS_WUKV), MTOK, 4096, KVLORA}; pg8::StaticOrder S; S.init(MTOK, 4096, C.G, (int)blockIdx.x);
                    pg8::EpiBf16<0> E{(bf16*)(BIG + BIG_KVRAW), 4096, RN_NONE}; pg8::gemm_phase<pg8::EpiBf16<0>, pg8::StaticOrder, true, true>(C.lds + RING_OFF, g, S, E, C.tid); } PHASE_END
                PHASE_BEGIN REP_BEGIN(3) phase_kv_build(C, (const bf16*)(BIG + BIG_KVRAW), (const float*)(BIG + BIG_CKV), args.k_norm, rope, (bf16*)(ws + WS_KB), (bf16*)(ws + WS_VB)); REP_END PHASE_END
            }
            PHASE_BEGIN { pg8::Gemm g{Hb, (const bf16*)(ws + WS_WDQ) + (size_t)j * DM * QLORA, MTOK, QLORA, DM}; pg8::StaticOrder S; S.init(MTOK, QLORA, C.G, (int)blockIdx.x);
                pg8::EpiLat E{(bf16*)(BIG + BIG_CQ), QLORA, DBG_OLD_MIX ? RN_NONE : pg8::RowNorm{SS + (size_t)(SS_MIX + layer) * MTOK, (const float*)(ws + WS_SW + SW_DQ) + (size_t)j * 8 * 512, 512, INV_D}, args.q_lat_norm + j * QLORA, SS + (size_t)(SS_CQ + j) * MTOK, nullptr, QLORA};
                pg8::gemm_phase<pg8::EpiLat, pg8::StaticOrder, true, true>(C.lds + RING_OFF, g, S, E, C.tid); } PHASE_END
            PHASE_BEGIN { pg8::Gemm g{(const bf16*)(BIG + BIG_CQ), (const bf16*)(ws + WS_WUQ) + (size_t)j * QLORA * 3072, MTOK, 3072, QLORA}; pg8::StaticOrder S; S.init(MTOK, 3072, C.G, (int)blockIdx.x);
                pg8::EpiBf16<0> E{(bf16*)(BIG + BIG_Q), 3072, pg8::RowNorm{SS + (size_t)(SS_CQ + j) * MTOK, nullptr, 0, INV_LAT}}; pg8::gemm_phase<pg8::EpiBf16<0>, pg8::StaticOrder, true, true>(C.lds + RING_OFF, g, S, E, C.tid); } PHASE_END
            PHASE_BEGIN phase_q_post(C, (bf16*)(BIG + BIG_Q), args.q_norm + j * QKD, rope); PHASE_END
            PHASE_BEGIN REP_BEGIN(1) att::attn_phase(C, (const bf16*)(BIG + BIG_Q), (const bf16*)(ws + WS_KB), (const bf16*)(ws + WS_VB), Hb); REP_END PHASE_END
            PHASE_BEGIN { pg8::Gemm g{Hb, (const bf16*)(ws + WS_WO) + (size_t)j * DM * DM, MTOK, DM, DM}; pg8::StaticOrder S; S.init(MTOK, DM, C.G, (int)blockIdx.x);
                #if DBG_OLD_RESID
                pg8::EpiResidOld E{X, X, DM, modl + 2 * DM, MODW}; pg8::gemm_phase<pg8::EpiResidOld, pg8::StaticOrder, true, true>(C.lds + RING_OFF, g, S, E, C.tid);
#else
                pg8::EpiResid E{X, X, DM, modl + 2 * DM, MODW, (DBG_THIN_XG || DBG_OLD_MLP) ? nullptr : XGB, args.norm_mlp + layer * DM, modl + 4 * DM, MODW, (DBG_THIN_XG || DBG_OLD_MLP) ? nullptr : SS + (size_t)(SS_MLP + layer) * MTOK, nullptr, nullptr, nullptr, 0};
                pg8::gemm_phase<pg8::EpiResid, pg8::StaticOrder, true, true>(C.lds + RING_OFF, g, S, E, C.tid);
#endif
 } PHASE_END
        }
#if DBG_THIN_XG
        PHASE_BEGIN phase_xg(C, X, args.norm_mlp + layer * DM, modl + 4 * DM, MODW, XGB, SS + (size_t)(SS_MLP + layer) * MTOK); PHASE_END
#endif
#if DBG_OLD_MLP
        PHASE_BEGIN phase_norm_mod<false>(C, X, args.norm_mlp + layer * DM, modl + 3 * DM, modl + 4 * DM, MODW, XGB, nullptr, nullptr, nullptr, 0, nullptr); PHASE_END
#endif
        PHASE_BEGIN REP_BEGIN(5) { pg8::Gemm g{XGB, (const bf16*)(ws + WS_W1) + (size_t)layer * DM * DFF, MTOK, DFF, DM}; pg8::StaticOrder S; S.init(MTOK, DFF, C.G, (int)blockIdx.x);
            pg8::EpiBf16<1> E{(bf16*)BIG, DFF, DBG_OLD_MLP ? RN_NONE : pg8::RowNorm{SS + (size_t)(SS_MLP + layer) * MTOK, (const float*)(ws + WS_SW + SW_1) + (size_t)layer * 8 * 8192, 8192, INV_D}};
            pg8::gemm_phase<pg8::EpiBf16<1>, pg8::StaticOrder, true, true>(C.lds + RING_OFF, g, S, E, C.tid); } REP_END PHASE_END
        PHASE_BEGIN { pg8::Gemm g{(const bf16*)BIG, (const bf16*)(ws + WS_W2) + (size_t)layer * DM * DFF, MTOK, DM, DFF}; pg8::StaticOrder S; S.init(MTOK, DM, C.G, (int)blockIdx.x);
            const bool nxt = !DBG_THIN_XG && !DBG_OLD_MIX && layer + 1 < DEPTH, kvs = !DBG_THIN_XG && !DBG_OLD_MIX && (layer + 1 == NA);
            const float* modn = mod + (size_t)(layer + 1) * NBATCH * MODW;
            #if DBG_OLD_RESID
                pg8::EpiResidOld E{X, X, DM, modl + 5 * DM, MODW}; pg8::gemm_phase<pg8::EpiResidOld, pg8::StaticOrder, true, true>(C.lds + RING_OFF, g, S, E, C.tid);
#else
                pg8::EpiResid E{X, X, DM, modl + 5 * DM, MODW, nxt ? Hb : nullptr, args.norm_mix + (layer + 1) * DM, modn + DM, MODW, nxt ? SS + (size_t)(SS_MIX + layer + 1) * MTOK : nullptr,
                            kvs ? HKV : nullptr, args.kv_in_norm, kvmod + DM, 2 * DM};
            pg8::gemm_phase<pg8::EpiResid, pg8::StaticOrder, true, true>(C.lds + RING_OFF, g, S, E, C.tid);
#endif
 } PHASE_END
    }
#undef PHASE_BEGIN
#undef PHASE_END
}

extern "C" void kernel_launch(void* const* d_in, const int* in_sizes, int n_in, void* d_out, int out_size, void* d_ws, size_t ws_size, hipStream_t stream) {
    static int grid = 0;
    if (grid == 0) {
        if (n_in != 25 || in_sizes[0] != MTOK * DM || out_size != MTOK * DM || ws_size < WS_END) {
            fprintf(stderr, "kernel_launch: unexpected shapes / workspace (n_in %d, in0 %d, out %d, ws %zu, need %zu); nothing launched\n", n_in, n_in > 0 ? in_sizes[0] : -1, out_size, ws_size, (size_t)WS_END); grid = -1; return; }
        int dev = 0, cus = 0, per_cu = 0;
        if (hipGetDevice(&dev) != hipSuccess || hipDeviceGetAttribute(&cus, hipDeviceAttributeMultiprocessorCount, dev) != hipSuccess) { grid = -1; return; }
        if (hipFuncSetAttribute((const void*)fwd_kernel, hipFuncAttributeMaxDynamicSharedMemorySize, LDS_BYTES) != hipSuccess) { fprintf(stderr, "kernel_launch: hipFuncSetAttribute failed\n"); grid = -1; return; }
        if (hipOccupancyMaxActiveBlocksPerMultiprocessor(&per_cu, (const void*)fwd_kernel, NWAVES * 64, LDS_BYTES) != hipSuccess || per_cu < 1)
            fprintf(stderr, "kernel_launch: note: occupancy query reports %d workgroups per CU\n", per_cu);
        (void)hipGetLastError();
        grid = cus;
    }
    if (grid < 0) return;
    if (hipMemsetAsync((char*)d_ws + WS_CTL, 0, CTL_ZERO_BYTES, stream) != hipSuccess) return;
    Args a{};
    a.x = (const float*)d_in[0]; a.c = (const float*)d_in[1]; a.positions = (const int*)d_in[2];
    a.ada_w = (const float*)d_in[3]; a.ada_b = (const float*)d_in[4]; a.norm_mix = (const float*)d_in[5]; a.norm_mlp = (const float*)d_in[6];
    a.mlp_w1 = (const float*)d_in[7]; a.mlp_w2 = (const float*)d_in[8]; a.hg_w_in = (const float*)d_in[9]; a.hg_lower = (const float*)d_in[10];
    a.hg_o_norm = (const float*)d_in[11]; a.hg_w_out = (const float*)d_in[12];
    a.kv_ada_w = (const float*)d_in[13]; a.kv_ada_b = (const float*)d_in[14]; a.kv_in_norm = (const float*)d_in[15]; a.w_dkv = (const float*)d_in[16];
    a.kv_norm = (const float*)d_in[17]; a.w_ukv = (const float*)d_in[18]; a.k_norm = (const float*)d_in[19];
    a.w_dq = (const float*)d_in[20]; a.q_lat_norm = (const float*)d_in[21]; a.w_uq = (const float*)d_in[22]; a.q_norm = (const float*)d_in[23]; a.w_o = (const float*)d_in[24];
    a.out = (float*)d_out; a.ws = (unsigned char*)d_ws;
#if MK_MULTI
    for (int p = 0; p < NPHASES; ++p) { a.ph_lo = p; a.ph_hi = p + 1; hipLaunchKernelGGL(fwd_kernel, dim3(grid), dim3(NWAVES * 64), LDS_BYTES, stream, a); }
#else
    a.ph_lo = 0; a.ph_hi = NPHASES;
    hipLaunchKernelGGL(fwd_kernel, dim3(grid), dim3(NWAVES * 64), LDS_BYTES, stream, a);
#endif
    const hipError_t le = hipPeekAtLastError();
    if (le != hipSuccess) fprintf(stderr, "kernel_launch: launch failed: %s\n", hipGetErrorName(le));
}
```
